# Optimizing an MI355X kernel written in HIP

```python
import jax
import jax.numpy as jnp
from jax import lax
import numpy as np

D_MODEL = 2048
BATCH = 2
SEQ = 4096
DEPTH = 4

GRID_W = 64
CTX_LEN = 256
N_MIXERS = 3
NORM_EPS = 1e-6

RW_HEAD = 64
RW_HEADS = D_MODEL // RW_HEAD
RW_DECAY_LORA = 96
RW_AAA_LORA = 96
RW_MV_LORA = 64
RW_GATE_LORA = 256
RW_GN_EPS = 64e-5

ATT_HEAD = 128
ATT_HEADS = D_MODEL // ATT_HEAD
GQA_KV_HEADS = 4
GQA_GROUP = ATT_HEADS // GQA_KV_HEADS
KV_DIM = GQA_KV_HEADS * ATT_HEAD
ROPE_THETA = 10000.0
Q_BLOCK = 128
NA_WIN_R = 8
NA_WIN_C = 16

D_FF = ((8 * D_MODEL // 3 + 255) // 256) * 256
CONV_W = 3

kernel_name = 'hybrid_rwkv7_natten_gqa_convffn_dit'


def rms_norm(x, g):
    xf = x.astype(jnp.float32)
    y = xf * lax.rsqrt(jnp.mean(xf * xf, axis=-1, keepdims=True) + NORM_EPS)
    return (y * g.astype(jnp.float32)).astype(x.dtype)


def modulate(h, shift, scale):
    return h * (1 + scale) + shift


def centred_shift(h):
    hp = jnp.pad(h, ((0, 0), (1, 1), (0, 0)))
    return 0.5 * (hp[:, :-2] + hp[:, 2:]) - h


def dwconv_seq(u, w, b):
    t = u.shape[1]
    p = CONV_W // 2
    up = jnp.pad(u, ((0, 0), (p, p), (0, 0)))
    y = b
    for j in range(CONV_W):
        y = y + up[:, j:j + t] * w[j]
    return y


def conv_ffn(h, w_up, conv_w, conv_b, w_down):
    u = dwconv_seq(h @ w_up, conv_w, conv_b)
    gate, val = jnp.split(u, 2, axis=-1)
    return (jax.nn.silu(gate) * val) @ w_down


def axial_rope(n_tok):
    t = jnp.arange(n_tok, dtype=jnp.int32)
    pos = jnp.stack([t // GRID_W, t % GRID_W], axis=-1).astype(jnp.float32)
    n_freq = ATT_HEAD // 4
    inv = ROPE_THETA ** (-jnp.arange(n_freq, dtype=jnp.float32) / n_freq)
    ang = pos[:, :, None] * inv
    return jnp.cos(ang), jnp.sin(ang)


def apply_rope(x, cos, sin):
    xf = x.astype(jnp.float32).reshape(x.shape[:-1] + (2, 2, ATT_HEAD // 4))
    x1, x2 = xf[..., 0, :], xf[..., 1, :]
    cs, sn = cos[None, :, None], sin[None, :, None]
    out = jnp.stack([x1 * cs - x2 * sn, x1 * sn + x2 * cs], axis=-2)
    return out.reshape(x.shape).astype(x.dtype)


def attend(q, k, v):
    s = jnp.einsum('bqhgd,bkhd->bhgqk', q, k, preferred_element_type=jnp.float32) * (ATT_HEAD ** -0.5)
    p = jax.nn.softmax(s, axis=-1).astype(v.dtype)
    return jnp.einsum('bhgqk,bkhd->bqhgd', p, v)


def gqa_mixer(hc, hl, w_qkv, q_g, k_g, w_o, cos, sin, need_ctx):
    b, n_lat, _ = hl.shape

    def proj(h):
        t = h.shape[1]
        q, k, v = jnp.split(h @ w_qkv, [D_MODEL, D_MODEL + KV_DIM], axis=-1)
        q = rms_norm(q.reshape(b, t, ATT_HEADS, ATT_HEAD), q_g)
        k = rms_norm(k.reshape(b, t, GQA_KV_HEADS, ATT_HEAD), k_g)
        return q, k, v.reshape(b, t, GQA_KV_HEADS, ATT_HEAD)

    ql, kl, vl = proj(hl)
    qc, kc, vc = proj(hc)
    ql = apply_rope(ql, cos, sin)
    kl = apply_rope(kl, cos, sin)
    keys = jnp.concatenate([kl, kc], axis=1)
    vals = jnp.concatenate([vl, vc], axis=1)
    nb = n_lat // Q_BLOCK
    qb = ql.reshape(b, nb, Q_BLOCK, GQA_KV_HEADS, GQA_GROUP, ATT_HEAD).swapaxes(0, 1)
    ob = lax.map(lambda qblk: attend(qblk, keys, vals), qb)
    out_l = ob.swapaxes(0, 1).reshape(b, n_lat, D_MODEL) @ w_o
    out_c = None
    if need_ctx:
        tc = hc.shape[1]
        oc = attend(qc.reshape(b, tc, GQA_KV_HEADS, GQA_GROUP, ATT_HEAD), kc, vc)
        out_c = oc.reshape(b, tc, D_MODEL) @ w_o
    return out_l, out_c


def na_mixer(hc, hl, w_qkv, q_g, k_g, rpb, w_o, need_ctx):
    b, n_lat, _ = hl.shape
    rows = n_lat // GRID_W
    kr = min(NA_WIN_R, rows)
    n_win = kr * NA_WIN_C
    scale = ATT_HEAD ** -0.5

    def proj(h):
        t = h.shape[1]
        q, k, v = jnp.split(h @ w_qkv, 3, axis=-1)
        shp = (b, t, ATT_HEADS, ATT_HEAD)
        return rms_norm(q.reshape(shp), q_g), rms_norm(k.reshape(shp), k_g), v.reshape(shp)

    ql, kl, vl = proj(hl)
    qc, kc, vc = proj(hc)
    grid = (b, rows, GRID_W, ATT_HEADS, ATT_HEAD)
    kg, vg = kl.reshape(grid), vl.reshape(grid)
    cols = jnp.arange(GRID_W)
    col_idx = jnp.clip(cols - NA_WIN_C // 2, 0, GRID_W - NA_WIN_C)[:, None] + jnp.arange(NA_WIN_C)
    rpb_c = rpb[:, :, col_idx - cols[:, None] + NA_WIN_C - 1]

    def row_block(args):
        r, q_r = args
        rs = jnp.clip(r - kr // 2, 0, rows - kr)
        k_win = lax.dynamic_slice_in_dim(kg, rs, kr, axis=1)[:, :, col_idx]
        v_win = lax.dynamic_slice_in_dim(vg, rs, kr, axis=1)[:, :, col_idx]
        bias = rpb_c[:, rs + jnp.arange(kr) - r + NA_WIN_R - 1]
        s_win = (jnp.einsum('bqhd,brqkhd->bhqrk', q_r, k_win, preferred_element_type=jnp.float32) * scale
                 + bias.transpose(0, 2, 1, 3)[None].astype(jnp.float32))
        s_ctx = jnp.einsum('bqhd,bkhd->bhqk', q_r, kc, preferred_element_type=jnp.float32) * scale
        p = jax.nn.softmax(jnp.concatenate([s_win.reshape(b, ATT_HEADS, GRID_W, n_win), s_ctx], axis=-1),
                           axis=-1).astype(v_win.dtype)
        return (jnp.einsum('bhqrk,brqkhd->bqhd', p[..., :n_win].reshape(s_win.shape), v_win)
                + jnp.einsum('bhqk,bkhd->bqhd', p[..., n_win:], vc))

    q_rows = ql.reshape(grid).swapaxes(0, 1)
    o = lax.map(row_block, (jnp.arange(rows), q_rows))
    out_l = o.swapaxes(0, 1).reshape(b, n_lat, D_MODEL) @ w_o
    out_c = None
    if need_ctx:
        tc = hc.shape[1]
        oc = attend(qc.reshape(b, tc, ATT_HEADS, 1, ATT_HEAD), kc, vc)
        out_c = oc.reshape(b, tc, D_MODEL) @ w_o
    return out_l, out_c


def to_heads(t):
    return t.reshape(t.shape[:-1] + (RW_HEADS, RW_HEAD)).astype(jnp.float32)


def dir_lora(z, p1, p2, act):
    return jnp.einsum('zbtl,zld->zbtd', act(jnp.einsum('btd,zdl->zbtl', z, p1)), p2)


def rwkv_stream(h, mu, w_rkv, w0, w1, w2, a0, a1, a2):
    xx = centred_shift(h)
    xm = h[None] + xx[None] * mu[:, None, None, :]
    r, k, v = jnp.einsum('pbtd,pde->pbte', xm[:3], w_rkv)
    wl = (w0[:, None, None] + dir_lora(xm[3], w1, w2, jnp.tanh)).astype(jnp.float32)
    decay = jnp.exp(-jnp.exp(-jax.nn.softplus(-wl) - 0.5))
    a = jax.nn.sigmoid((a0[:, None, None] + dir_lora(xm[4], a1, a2, lambda t: t)).astype(jnp.float32))
    return r, k, v, xm[2], xm[5], to_heads(decay), to_heads(a)


def wkv_scan(r, w, kk, a, k, v, s0, reverse, emit):
    def step(s, inp):
        r_t, w_t, kk_t, a_t, k_t, v_t = inp
        s_kk = jnp.einsum('bhvk,bhk->bhv', s, kk_t)
        s = (s * w_t[:, :, None, :] - s_kk[..., None] * (kk_t * a_t)[:, :, None, :]
             + v_t[..., None] * k_t[:, :, None, :])
        y = jnp.einsum('bhvk,bhk->bhv', s, r_t) if emit else None
        return s, y
    xs = tuple(jnp.moveaxis(t, 1, 0) for t in (r, w, kk, a, k, v))
    s_fin, ys = lax.scan(step, s0, xs, reverse=reverse)
    return s_fin, (jnp.moveaxis(ys, 0, 1) if emit else None)


def rwkv_time_mix(hc, hl, v_first, mu, w_rkv, w0, w1, w2, a0, a1, a2, g1, g2, k_k, k_a, r_k,
                  ln_g, ln_b, w_o, vres, need_ctx):
    feats = []
    firsts = []
    for n, h in enumerate((hc, hl)):
        r, k, v, xv, xg, decay, a = rwkv_stream(h, mu, w_rkv, w0, w1, w2, a0, a1, a2)
        if vres is None:
            firsts.append(v)
        else:
            v0, v1, v2 = vres
            v = v + (v_first[n] - v) * jax.nn.sigmoid(v0 + (xv @ v1) @ v2)
        kk = to_heads(k * k_k)
        kk = kk * lax.rsqrt(jnp.maximum(jnp.sum(kk * kk, axis=-1, keepdims=True), 1e-24))
        kd = to_heads(k)[None] * (1 + (a - 1) * to_heads(k_a))
        feats.append((to_heads(r), kk, to_heads(v), decay, a, kd, xg))
    if vres is None:
        v_first = (firsts[0], firsts[1])
    (rc, kkc, vc, dc, ac, kdc, xgc), (rl, kkl, vl, dl, al, kdl, xgl) = feats
    b = hl.shape[0]
    y_c = 0.0
    y_l = 0.0
    for d, rev in enumerate((False, True)):
        s0 = jnp.zeros((b, RW_HEADS, RW_HEAD, RW_HEAD), jnp.float32)
        s_c, yc_d = wkv_scan(rc, dc[d], kkc, ac[d], kdc[d], vc, s0, rev, need_ctx)
        _, yl_d = wkv_scan(rl, dl[d], kkl, al[d], kdl[d], vl, s_c, rev, True)
        y_l = y_l + yl_d
        if need_ctx:
            y_c = y_c + yc_d

    def readout(h, y, r, kd, v, xg):
        mean = jnp.mean(y, axis=-1, keepdims=True)
        var = jnp.mean(jnp.square(y - mean), axis=-1, keepdims=True)
        yn = (y - mean) * lax.rsqrt(var + RW_GN_EPS)
        bonus = jnp.sum(jnp.sum(r[None] * kd * r_k.astype(jnp.float32), axis=-1, keepdims=True), axis=0) * v
        o = (yn.reshape(h.shape) * ln_g + ln_b + bonus.reshape(h.shape)).astype(h.dtype)
        g = jax.nn.sigmoid(xg @ g1) @ g2
        return (o * g) @ w_o

    out_l = readout(hl, y_l, rl, kdl, vl, xgl)
    out_c = readout(hc, y_c, rc, kdc, vc, xgc) if need_ctx else None
    return out_l, out_c, v_first


def setup_inputs(seed: int = 0) -> dict:
    key = jax.random.key(seed)
    keys = jax.random.split(key, 48)
    ctr = [0]

    def nk():
        ctr[0] += 1
        return keys[ctr[0] - 1]

    def nrm(shape, std=1.0):
        return std * jax.random.normal(nk(), shape, jnp.float32)

    def uni(shape, lo, hi):
        return jax.random.uniform(nk(), shape, jnp.float32, lo, hi)

    d = D_MODEL
    f = D_FF
    n_a = len(range(0, DEPTH, N_MIXERS))
    n_b = len(range(1, DEPTH, N_MIXERS))
    n_c = len(range(2, DEPTH, N_MIXERS))
    n_vr = max(n_a - 1, 0)
    return {
        'x': nrm((BATCH, SEQ, d)),
        'c': nrm((BATCH, d)),
        'ctx': nrm((BATCH, CTX_LEN, d)),
        'c_ctx': nrm((d,)),
        'mod_w': nrm((DEPTH, d, 6 * d), d ** -0.5),
        'mod_b': nrm((DEPTH, 6 * d), 0.02),
        'norm1_g': 1.0 + nrm((DEPTH, d), 0.02),
        'norm2_g': 1.0 + nrm((DEPTH, d), 0.02),
        'ffn_up': nrm((DEPTH, d, 2 * f), d ** -0.5),
        'ffn_conv_w': nrm((DEPTH, CONV_W, 2 * f), CONV_W ** -0.5),
        'ffn_conv_b': nrm((DEPTH, 2 * f), 0.02),
        'ffn_down': nrm((DEPTH, f, d), f ** -0.5),
        'rw_mu': uni((n_a, 6, d), 0.0, 1.0),
        'rw_w_rkv': nrm((n_a, 3, d, d), d ** -0.5),
        'rw_w0': uni((n_a, 2, d), -6.0, 0.0),
        'rw_w1': nrm((n_a, 2, d, RW_DECAY_LORA), d ** -0.5),
        'rw_w2': nrm((n_a, 2, RW_DECAY_LORA, d), 0.1 * RW_DECAY_LORA ** -0.5),
        'rw_a0': nrm((n_a, 2, d), 0.1),
        'rw_a1': nrm((n_a, 2, d, RW_AAA_LORA), d ** -0.5),
        'rw_a2': nrm((n_a, 2, RW_AAA_LORA, d), 0.1 * RW_AAA_LORA ** -0.5),
        'rw_g1': nrm((n_a, d, RW_GATE_LORA), d ** -0.5),
        'rw_g2': nrm((n_a, RW_GATE_LORA, d), RW_GATE_LORA ** -0.5),
        'rw_k_k': 0.85 + nrm((n_a, d), 0.02),
        'rw_k_a': 1.0 + nrm((n_a, d), 0.02),
        'rw_r_k': nrm((n_a, RW_HEADS, RW_HEAD), 0.1),
        'rw_ln_g': 1.0 + nrm((n_a, d), 0.02),
        'rw_ln_b': nrm((n_a, d), 0.02),
        'rw_w_o': nrm((n_a, d, d), d ** -0.5),
        'rw_v0': 1.0 + nrm((n_vr, d), 0.1),
        'rw_v1': nrm((n_vr, d, RW_MV_LORA), d ** -0.5),
        'rw_v2': nrm((n_vr, RW_MV_LORA, d), 0.1 * RW_MV_LORA ** -0.5),
        'na_w_qkv': nrm((n_b, d, 3 * d), d ** -0.5),
        'na_q_g': 1.0 + nrm((n_b, ATT_HEAD), 0.02),
        'na_k_g': 1.0 + nrm((n_b, ATT_HEAD), 0.02),
        'na_rpb': nrm((n_b, ATT_HEADS, 2 * NA_WIN_R - 1, 2 * NA_WIN_C - 1), 0.1),
        'na_w_o': nrm((n_b, d, d), d ** -0.5),
        'ga_w_qkv': nrm((n_c, d, d + 2 * KV_DIM), d ** -0.5),
        'ga_q_g': 1.0 + nrm((n_c, ATT_HEAD), 0.02),
        'ga_k_g': 1.0 + nrm((n_c, ATT_HEAD), 0.02),
        'ga_w_o': nrm((n_c, d, d), d ** -0.5),
    }


def reference(x, c, ctx, c_ctx, mod_w, mod_b, norm1_g, norm2_g, ffn_up, ffn_conv_w, ffn_conv_b, ffn_down,
              rw_mu, rw_w_rkv, rw_w0, rw_w1, rw_w2, rw_a0, rw_a1, rw_a2, rw_g1, rw_g2, rw_k_k, rw_k_a,
              rw_r_k, rw_ln_g, rw_ln_b, rw_w_o, rw_v0, rw_v1, rw_v2,
              na_w_qkv, na_q_g, na_k_g, na_rpb, na_w_o,
              ga_w_qkv, ga_q_g, ga_k_g, ga_w_o):
    b, n_lat, d = x.shape
    cos, sin = axial_rope(n_lat)
    s_lat = jax.nn.silu(c)
    s_ctx = jax.nn.silu(c_ctx)
    xc = ctx
    v_first = None
    for i in range(DEPTH):
        kind, j = i % N_MIXERS, i // N_MIXERS
        need_ctx = i < DEPTH - 1
        m_l = (s_lat @ mod_w[i] + mod_b[i]).reshape(b, 1, 6, d)
        m_c = (s_ctx @ mod_w[i] + mod_b[i]).reshape(6, d)
        hl = modulate(rms_norm(x, norm1_g[i]), m_l[:, :, 0], m_l[:, :, 1])
        hc = modulate(rms_norm(xc, norm1_g[i]), m_c[0], m_c[1])
        if kind == 0:
            vres = None if j == 0 else (rw_v0[j - 1], rw_v1[j - 1], rw_v2[j - 1])
            o_l, o_c, v_first = rwkv_time_mix(hc, hl, v_first, rw_mu[j], rw_w_rkv[j], rw_w0[j], rw_w1[j],
                                              rw_w2[j], rw_a0[j], rw_a1[j], rw_a2[j], rw_g1[j], rw_g2[j],
                                              rw_k_k[j], rw_k_a[j], rw_r_k[j], rw_ln_g[j], rw_ln_b[j],
                                              rw_w_o[j], vres, need_ctx)
        elif kind == 1:
            o_l, o_c = na_mixer(hc, hl, na_w_qkv[j], na_q_g[j], na_k_g[j], na_rpb[j], na_w_o[j], need_ctx)
        else:
            o_l, o_c = gqa_mixer(hc, hl, ga_w_qkv[j], ga_q_g[j], ga_k_g[j], ga_w_o[j], cos, sin, need_ctx)
        x = x + m_l[:, :, 2] * o_l
        h2 = modulate(rms_norm(x, norm2_g[i]), m_l[:, :, 3], m_l[:, :, 4])
        x = x + m_l[:, :, 5] * conv_ffn(h2, ffn_up[i], ffn_conv_w[i], ffn_conv_b[i], ffn_down[i])
        if need_ctx:
            xc = xc + m_c[2] * o_c
            h2c = modulate(rms_norm(xc, norm2_g[i]), m_c[3], m_c[4])
            xc = xc + m_c[5] * conv_ffn(h2c, ffn_up[i], ffn_conv_w[i], ffn_conv_b[i], ffn_down[i])
    return x
```

```cpp
#include <hip/hip_runtime.h>
#include <cstdio>
#include <cstdint>

#ifndef MK_ONE_LAUNCH
#define MK_ONE_LAUNCH 1
#endif

constexpr int D = 2048, NB = 2, SEQ = 4096, CTXL = 256, DEPTH = 4;
constexpr int SB = SEQ + CTXL;
constexpr int M = NB * SB;
constexpr int NMB = M / 256;
constexpr int DFF = 5632, DFF2 = 11264;
constexpr int HD = 128, NH = 16, KVH = 4, KVD = 512;
constexpr int RNH = 32;
constexpr float NORM_EPS = 1e-6f, GN_EPS = 64e-5f;

#define GAS __attribute__((address_space(1)))
#define LAS __attribute__((address_space(3)))
typedef unsigned short bf16;
typedef unsigned v4u __attribute__((ext_vector_type(4)));
typedef unsigned v2u __attribute__((ext_vector_type(2)));
typedef float f32x4 __attribute__((ext_vector_type(4)));
typedef float f32x2 __attribute__((ext_vector_type(2)));
typedef short bf16x8 __attribute__((ext_vector_type(8)));

__device__ __forceinline__ int ltid() { int t = threadIdx.x; asm volatile("" : "+v"(t)); return t; }
__device__ __forceinline__ float bflo(unsigned u) { return __uint_as_float(u << 16); }
__device__ __forceinline__ float bfhi(unsigned u) { return __uint_as_float(u & 0xffff0000u); }
__device__ __forceinline__ unsigned cvt_pk_bf16(float lo, float hi) { unsigned r; asm volatile("v_cvt_pk_bf16_f32 %0, %1, %2" : "=v"(r) : "v"(lo), "v"(hi)); return r; }
typedef __bf16 bf16x2_t __attribute__((ext_vector_type(2)));
__device__ __forceinline__ unsigned cvt_pk_bf16_v(float lo, float hi) { const f32x2 v = {lo, hi}; return __builtin_bit_cast(unsigned, __builtin_convertvector(v, bf16x2_t)); }
__device__ __forceinline__ float sigmoidf_(float x) { return __builtin_amdgcn_rcpf(1.0f + __expf(-x)); }
__device__ __forceinline__ float wave_sum(float v) {
#pragma unroll
    for (int o = 1; o < 64; o <<= 1) v += __shfl_xor(v, o);
    return v;
}
template <int CTRL> __device__ __forceinline__ float dppmov(float v) { return __builtin_bit_cast(float, __builtin_amdgcn_update_dpp(0, __builtin_bit_cast(int, v), CTRL, 0xF, 0xF, true)); }
__device__ __forceinline__ float sum16(float v) {
    v += dppmov<0xB1>(v); v += dppmov<0x4E>(v); v += dppmov<0x141>(v); v += dppmov<0x140>(v); return v;
}

constexpr size_t MiB = 1u << 20;
constexpr size_t WS_CTL = 0, CTL_ZERO_BYTES = 1 * MiB;
constexpr size_t WS_MOD = 1 * MiB;
constexpr size_t WS_X = 2 * MiB;
constexpr size_t WS_H = 70 * MiB;
constexpr size_t WS_O = 104 * MiB;
constexpr size_t WS_V0 = 138 * MiB;
constexpr size_t WS_UPT = 172 * MiB;
constexpr size_t WS_DNT = 348 * MiB;
constexpr size_t WS_RWT = 436 * MiB;
constexpr size_t WS_RL2T = 492 * MiB;
constexpr size_t WS_RWOT = 504 * MiB;
constexpr size_t WS_NAQKVT = 520 * MiB;
constexpr size_t WS_NAOT = 544 * MiB;
constexpr size_t WS_GAQKVT = 552 * MiB;
constexpr size_t WS_GAOT = 564 * MiB;
constexpr size_t WS_S0 = 572 * MiB;
constexpr size_t WS_RKV = WS_S0;
constexpr size_t WS_L1O = WS_S0 + 102 * MiB;
constexpr size_t WS_DEC = WS_S0 + 119 * MiB;
constexpr size_t WS_AA = WS_S0 + 255 * MiB;
constexpr size_t WS_GG = WS_S0 + 323 * MiB;
constexpr size_t WS_VG = WS_S0 + 357 * MiB;
constexpr size_t WS_PART = WS_S0 + 391 * MiB;
constexpr size_t WS_Y = WS_S0 + 435 * MiB;
constexpr size_t WS_XM = WS_S0 + 571 * MiB;
constexpr size_t WS_OPS = WS_S0 + 571 * MiB;
constexpr size_t WS_BON = WS_S0 + 435 * MiB + 72 * MiB;
constexpr size_t WS_H32 = WS_DEC;
constexpr size_t WS_QKV = WS_S0;
constexpr size_t WS_ACT = WS_S0 + 188 * MiB;
constexpr size_t WS_HALO = WS_S0 + 282 * MiB;
constexpr size_t WS_END = WS_S0 + 945 * MiB;
constexpr size_t SZ_ACT = (size_t)M * D * 2;

namespace pg8 {
#define PG8_LAS __attribute__((address_space(3)))
typedef unsigned short bf16_t;
typedef unsigned u32x4 __attribute__((ext_vector_type(4)));
constexpr int BM = 256, BK = 64, HALF = 128, HTB = HALF * BK * 2, STAGE_BYTES = 8 * HTB, NXCD = 8, WGM = 4;

__host__ __device__ __forceinline__ int lds_byte(int r, int c) { const int st = (r >> 4) * 2 + (c >> 5), rr = r & 15, cc = c & 31, ob = rr * 64 + cc * 2; return st * 1024 + (ob ^ (((ob >> 9) & 1) << 5)); }
__host__ __device__ __forceinline__ void stage_rc(int b, int& R, int& C) { const int st = b / 1024, sb = b % 1024, swz = sb ^ (((sb >> 9) & 1) << 5); R = (st >> 1) * 16 + swz / 64; C = (st & 1) * 32 + (swz % 64) / 2; }
__host__ __device__ __forceinline__ int perm32(int rho) { const int n = rho >> 4, i = rho & 15; return 8 * (i >> 2) + 4 * n + (i & 3); }

struct Unit { int pm, pn, lm, ln, sub, kofs, nt, kpart; };
struct Gemm { const bf16_t* A; const bf16_t* Bt; int K; };

struct SubP { int nN, pmBase, pnBase, cum; };
struct OrdTab { int nsub, total, pad0, pad1; SubP sp[8]; };

struct MultiOrder {
    const OrdTab* T; int nM, G, c, lat_only, nt;
    __device__ __forceinline__ bool next(int i, Unit& u) const {
        const int total = lat_only ? T->total / 34 * 32 : T->total;
        const long L = (long)i * G + c; if (L >= total) return false;
        int w = (int)L; { const int q = total / NXCD, r = total % NXCD, xcd = w % NXCD, off = w / NXCD; w = (xcd < r ? xcd * (q + 1) : r * (q + 1) + (xcd - r) * q) + off; }
        int s = 0; const int ns = T->nsub; const int nMe = lat_only ? 32 : nM;
        if (lat_only) { while (s + 1 < ns && w >= T->sp[s + 1].cum / 34 * 32) ++s; }
        else { while (s + 1 < ns && w >= T->sp[s + 1].cum) ++s; }
        const int lw = w - (lat_only ? T->sp[s].cum / 34 * 32 : T->sp[s].cum), nN = T->sp[s].nN;
        const int nig = WGM * nN, gid = lw / nig, fm = gid * WGM, gsz = (nMe - fm) < WGM ? (nMe - fm) : WGM;
        int lm = fm + ((lw % nig) % gsz); const int ln = (lw % nig) / gsz;
        if (lat_only) lm += (lm >= 16) ? 1 : 0;
        u.lm = lm; u.ln = ln; u.sub = s; u.pm = T->sp[s].pmBase + lm; u.pn = T->sp[s].pnBase + ln; u.kofs = 0; u.nt = nt; u.kpart = -1;
        if (T->pad0) { if (s < 2) { u.kofs = (ln >> 3) * 128; u.nt = 2; } else if (s == 3) u.nt = 2; }
        return true;
    }
};
struct SplitCtxOrder {
    int G, c, ntFull, KS, ntPart, with_ctx;
    __device__ __forceinline__ bool next(int i, Unit& u) const {
        const long L = (long)i * G + c; const int nfull = 256, total = nfull + (with_ctx ? 16 * KS : 0);
        if (L >= total) return false;
        int w = (int)L; u.sub = 0;
        if (w < nfull) {
            { const int q = nfull / NXCD, xcd = w % NXCD, off = w / NXCD; w = xcd * q + off; }
            const int nig = WGM * 8, gid = w / nig, fm = gid * WGM; const int lml = fm + ((w % nig) % WGM); u.ln = (w % nig) / WGM;
            u.lm = lml + (lml >= 16 ? 1 : 0); u.kofs = 0; u.nt = ntFull; u.kpart = -1;
        } else {
            w -= nfull; const int kp = w % KS, t = w / KS;
            u.lm = (t >> 3) ? 33 : 16; u.ln = t & 7; u.kofs = kp * ntPart * BK; u.nt = ntPart; u.kpart = kp;
        }
        u.pm = u.lm; u.pn = u.ln; return true;
    }
};

template <class Epi, class Sched, bool ALIGN_EPI = false, bool SP2 = false>
__device__ __forceinline__ void gemm_phase(PG8_LAS unsigned char* lds, const Gemm g, const Sched& S, const Epi& E) {
    const int tid = ltid(), wid = __builtin_amdgcn_readfirstlane(tid >> 6), lane = tid & 63, wr = wid >> 2, wc = wid & 3, fr = lane & 15, fq = lane >> 4;
    int K = g.K; asm volatile("" : "+s"(K));
    unsigned voffA[2], voffB[2];
#pragma unroll
    for (int i = 0; i < 2; ++i) { int R, C; stage_rc(tid * 16 + i * 8192, R, C); const int Rb = Epi::PERM ? ((R & ~31) + perm32(R & 31)) : R;
        voffA[i] = (unsigned)(R * K + C) * 2u; voffB[i] = (unsigned)(Rb * K + C) * 2u; }
    const size_t kstep = (size_t)(BK * 2);
    const size_t hstep = (size_t)HALF * K * 2;
    const size_t tstep = 2 * hstep;
    const unsigned ldsw = (unsigned)wid * 1024u;
    const int aoff = lds_byte(wr * 64 + fr, fq * 8), boff = lds_byte(wc * 32 + fr, fq * 8);
#define PG8_SA(b, h) (((b) * 2 + (h)) * HTB)
#define PG8_SB(b, h) ((4 + (b) * 2 + (h)) * HTB)
#define PG8_STAGE(bufoff, gbase, voff) do { _Pragma("unroll") for (int _i = 0; _i < 2; ++_i) \
        __builtin_amdgcn_global_load_lds((const unsigned*)((const char*)(gbase) + (voff)[_i]), (PG8_LAS unsigned*)(lds + (bufoff) + ldsw + _i * 8192), 16, 0, 0); } while (0)
#define PG8_LDA(dst, b, h) do { _Pragma("unroll") for (int m = 0; m < 4; ++m) _Pragma("unroll") for (int k = 0; k < 2; ++k) dst[m][k] = *(const PG8_LAS bf16x8*)(lds + PG8_SA(b, h) + aoff + m * 2048 + k * 1024); } while (0)
#define PG8_LDB(dst, b, h) do { _Pragma("unroll") for (int n = 0; n < 2; ++n) _Pragma("unroll") for (int k = 0; k < 2; ++k) dst[n][k] = *(const PG8_LAS bf16x8*)(lds + PG8_SB(b, h) + boff + n * 2048 + k * 1024); } while (0)
#define PG8_MMA(ai, bj, At, Bt) do { __builtin_amdgcn_s_setprio(1); _Pragma("unroll") for (int m = 0; m < 4; ++m) _Pragma("unroll") for (int n = 0; n < 2; ++n) _Pragma("unroll") for (int k = 0; k < 2; ++k) \
        acc[ai][bj][m][n] = __builtin_amdgcn_mfma_f32_16x16x32_bf16(Bt[n][k], At[m][k], acc[ai][bj][m][n], 0, 0, 0); __builtin_amdgcn_s_setprio(0); } while (0)
#define PG8_WAIT_V(n) asm volatile("s_waitcnt vmcnt(" #n ")" ::: "memory")
#define PG8_WAIT_L(n) asm volatile("s_waitcnt lgkmcnt(" #n ")" ::: "memory")
#define PG8_BAR __builtin_amdgcn_s_barrier()
#define PG8_SCHED __builtin_amdgcn_sched_barrier(0)
    Unit cur, nxt; int ui = 0;
    if (!S.next(0, cur)) return;
    f32x4 acc[2][2][4][2];
#pragma unroll
    for (int a = 0; a < 2; ++a)
#pragma unroll
        for (int b = 0; b < 2; ++b)
#pragma unroll
            for (int m = 0; m < 4; ++m)
#pragma unroll
                for (int n = 0; n < 2; ++n) acc[a][b][m][n] = (f32x4){0.f, 0.f, 0.f, 0.f};
    bf16x8 At[4][2], B0[2][2], B1[2][2];
    const char* cA = (const char*)g.A + (size_t)cur.pm * tstep + (size_t)cur.kofs * 2; const char* cB = (const char*)g.Bt + (size_t)cur.pn * tstep + (size_t)cur.kofs * 2;
    if constexpr (SP2) {
        PG8_STAGE(PG8_SB(0, 0), cB, voffB); PG8_STAGE(PG8_SB(0, 1), cB + hstep, voffB); PG8_STAGE(PG8_SA(0, 0), cA, voffA); PG8_STAGE(PG8_SA(0, 1), cA + hstep, voffA);
        if (wr == 1) PG8_BAR;
        PG8_WAIT_V(2); PG8_BAR;
        PG8_STAGE(PG8_SB(1, 0), cB + kstep, voffB); PG8_STAGE(PG8_SA(1, 0), cA + kstep, voffA); PG8_STAGE(PG8_SB(1, 1), cB + hstep + kstep, voffB);
        PG8_WAIT_V(6); PG8_BAR;
    } else {
        PG8_STAGE(PG8_SB(0, 0), cB, voffB); PG8_STAGE(PG8_SA(0, 0), cA, voffA); PG8_STAGE(PG8_SB(0, 1), cB + hstep, voffB); PG8_STAGE(PG8_SA(0, 1), cA + hstep, voffA);
        if (wr == 1) PG8_BAR;
        PG8_WAIT_V(4); PG8_BAR;
        PG8_STAGE(PG8_SB(1, 0), cB + kstep, voffB); PG8_STAGE(PG8_SA(1, 0), cA + kstep, voffA); PG8_STAGE(PG8_SB(1, 1), cB + hstep + kstep, voffB);
        PG8_WAIT_V(6); PG8_BAR;
    }
    for (;;) {
        const bool has_next = S.next(ui + 1, nxt);
        const char* nA = has_next ? (const char*)g.A + (size_t)nxt.pm * tstep + (size_t)nxt.kofs * 2 : cA; const char* nB = has_next ? (const char*)g.Bt + (size_t)nxt.pn * tstep + (size_t)nxt.kofs * 2 : cB;
        const int nt = cur.nt;
        for (int t = 0; t < nt; t += 2) {
            const bool last = (t == nt - 2);
            const char* a1 = cA + (size_t)(t + 1) * kstep;
            const char* a2 = last ? nA : cA + (size_t)(t + 2) * kstep; const char* b2 = last ? nB : cB + (size_t)(t + 2) * kstep;
            const char* a3 = a2 + kstep; const char* b3 = b2 + kstep;
            if constexpr (SP2) {
            PG8_LDB(B0, 0, 0); PG8_LDB(B1, 0, 1); PG8_SCHED; PG8_LDA(At, 0, 0); PG8_STAGE(PG8_SA(1, 1), a1 + hstep, voffA);
            PG8_WAIT_V(8); PG8_WAIT_L(0); PG8_BAR; PG8_MMA(0, 0, At, B0); PG8_MMA(0, 1, At, B1); PG8_BAR; PG8_SCHED;
            PG8_LDA(At, 0, 1); PG8_STAGE(PG8_SB(0, 0), b2, voffB); PG8_STAGE(PG8_SB(0, 1), b2 + hstep, voffB); PG8_STAGE(PG8_SA(0, 0), a2, voffA);
            PG8_WAIT_V(8); PG8_WAIT_L(0); PG8_BAR; PG8_MMA(1, 0, At, B0); PG8_MMA(1, 1, At, B1); PG8_BAR; PG8_SCHED;
            PG8_LDB(B0, 1, 0); PG8_LDB(B1, 1, 1); PG8_SCHED; PG8_LDA(At, 1, 0); PG8_STAGE(PG8_SA(0, 1), a2 + hstep, voffA);
            PG8_WAIT_V(8); PG8_WAIT_L(0); PG8_BAR; PG8_MMA(0, 0, At, B0); PG8_MMA(0, 1, At, B1); PG8_BAR; PG8_SCHED;
            PG8_LDA(At, 1, 1); PG8_STAGE(PG8_SB(1, 0), b3, voffB); PG8_STAGE(PG8_SB(1, 1), b3 + hstep, voffB); PG8_STAGE(PG8_SA(1, 0), a3, voffA);
            PG8_WAIT_V(8); PG8_WAIT_L(0); PG8_BAR; PG8_MMA(1, 0, At, B0); PG8_MMA(1, 1, At, B1); PG8_BAR; PG8_SCHED;
            } else {
            PG8_LDB(B0, 0, 0); PG8_SCHED; PG8_LDA(At, 0, 0); PG8_STAGE(PG8_SA(1, 1), a1 + hstep, voffA);
            PG8_WAIT_L(8); PG8_BAR; PG8_WAIT_L(0); PG8_MMA(0, 0, At, B0); PG8_BAR; PG8_SCHED;
            PG8_LDB(B1, 0, 1); PG8_STAGE(PG8_SB(0, 0), b2, voffB);
            PG8_BAR; PG8_WAIT_L(0); PG8_MMA(0, 1, At, B1); PG8_BAR;
            PG8_LDA(At, 0, 1); PG8_STAGE(PG8_SA(0, 0), a2, voffA);
            PG8_BAR; PG8_WAIT_L(0); PG8_MMA(1, 0, At, B0); PG8_BAR; PG8_SCHED;
            PG8_STAGE(PG8_SB(0, 1), b2 + hstep, voffB);
            PG8_WAIT_V(6); PG8_BAR; PG8_MMA(1, 1, At, B1); PG8_BAR;
            PG8_LDB(B0, 1, 0); PG8_SCHED; PG8_LDA(At, 1, 0); PG8_STAGE(PG8_SA(0, 1), a2 + hstep, voffA);
            PG8_WAIT_L(8); PG8_BAR; PG8_WAIT_L(0); PG8_MMA(0, 0, At, B0); PG8_BAR; PG8_SCHED;
            PG8_LDB(B1, 1, 1); PG8_STAGE(PG8_SB(1, 0), b3, voffB);
            PG8_BAR; PG8_WAIT_L(0); PG8_MMA(0, 1, At, B1); PG8_BAR;
            PG8_LDA(At, 1, 1); PG8_STAGE(PG8_SA(1, 0), a3, voffA);
            PG8_BAR; PG8_WAIT_L(0); PG8_MMA(1, 0, At, B0); PG8_BAR; PG8_SCHED;
            PG8_STAGE(PG8_SB(1, 1), b3 + hstep, voffB);
            PG8_WAIT_V(6); PG8_BAR; PG8_MMA(1, 1, At, B1); PG8_BAR;
            }
        }
        if constexpr (ALIGN_EPI) { if (wr == 0) PG8_BAR; }
        E(acc, cur, wr, wc, fr, fq);
        if (!has_next) break;
#pragma unroll
        for (int a = 0; a < 2; ++a)
#pragma unroll
            for (int b = 0; b < 2; ++b)
#pragma unroll
                for (int m = 0; m < 4; ++m)
#pragma unroll
                    for (int n = 0; n < 2; ++n) acc[a][b][m][n] = (f32x4){0.f, 0.f, 0.f, 0.f};
        cur = nxt; cA = nA; cB = nB; ++ui;
        if constexpr (ALIGN_EPI) { if (wr == 1) PG8_BAR; }
    }
    PG8_WAIT_V(0);
    if constexpr (!ALIGN_EPI) { if (wr == 0) PG8_BAR; }
    PG8_BAR;
#undef PG8_SA
#undef PG8_SB
#undef PG8_STAGE
#undef PG8_LDA
#undef PG8_LDB
#undef PG8_MMA
#undef PG8_WAIT_V
#undef PG8_WAIT_L
#undef PG8_BAR
#undef PG8_SCHED
}
}

enum { ORD_RW0 = 0, ORD_RW1, ORD_L20, ORD_L21, ORD_N8, ORD_N24, ORD_N12, ORD_N44, ORD_N };
#define SUBS1(n) {1, 34 * (n), 0, 0, {{(n), 0, 0, 0}, {0,0,0,0},{0,0,0,0},{0,0,0,0},{0,0,0,0},{0,0,0,0},{0,0,0,0},{0,0,0,0}}}
__constant__ pg8::OrdTab g_ord[ORD_N] = {
    {6, 34 * 27, 0, 0, {{8, 0, 0, 0}, {8, 34, 8, 34 * 8}, {8, 68, 16, 34 * 16}, {1, 102, 24, 34 * 24}, {1, 136, 25, 34 * 25}, {1, 170, 26, 34 * 26}, {0,0,0,0}, {0,0,0,0}}},
    {7, 34 * 28, 0, 0, {{8, 0, 0, 0}, {8, 34, 8, 34 * 8}, {8, 68, 16, 34 * 16}, {1, 102, 24, 34 * 24}, {1, 136, 25, 34 * 25}, {1, 170, 26, 34 * 26}, {1, 68, 27, 34 * 27}, {0,0,0,0}}},
    {3, 34 * 40, 1, 0, {{16, 0, 0, 0}, {16, 34, 16, 34 * 16}, {8, 68, 32, 34 * 32}, {0,0,0,0},{0,0,0,0},{0,0,0,0},{0,0,0,0},{0,0,0,0}}},
    {4, 34 * 48, 1, 0, {{16, 0, 0, 0}, {16, 34, 16, 34 * 16}, {8, 68, 32, 34 * 32}, {8, 102, 40, 34 * 40}, {0,0,0,0},{0,0,0,0},{0,0,0,0},{0,0,0,0}}},
    SUBS1(8), SUBS1(24), SUBS1(12), SUBS1(44)
};
struct OutDesc { unsigned long long off; int ldc, mode, nsplit; unsigned long long split_stride; int bias_in, bias_off; };
enum { OD_RW0 = 0, OD_RW1, OD_L20, OD_L21, OD_NAQKV, OD_GAQKV, OD_UP, OD_N };
#define ODZ {0, 0, 0, 1, 0, -1, 0}
__constant__ OutDesc g_od[OD_N][8] = {
    { {WS_RKV, 2048, 0, 1 << 20, 0, -1, 0}, {WS_RKV + SZ_ACT, 2048, 0, 1 << 20, 0, -1, 0}, {WS_V0, 2048, 0, 1 << 20, 0, -1, 0},
      {WS_L1O, 256, 1, 1 << 20, 0, -1, 0}, {WS_L1O + (size_t)M * 512, 256, 0, 1 << 20, 0, -1, 0}, {WS_L1O + (size_t)M * 1024, 256, 2, 1 << 20, 0, -1, 0}, ODZ, ODZ },
    { {WS_RKV, 2048, 0, 1 << 20, 0, -1, 0}, {WS_RKV + SZ_ACT, 2048, 0, 1 << 20, 0, -1, 0}, {WS_RKV + 2 * SZ_ACT, 2048, 0, 1 << 20, 0, -1, 0},
      {WS_L1O, 256, 1, 1 << 20, 0, -1, 0}, {WS_L1O + (size_t)M * 512, 256, 0, 1 << 20, 0, -1, 0}, {WS_L1O + (size_t)M * 1024, 256, 2, 1 << 20, 0, -1, 0},
      {WS_L1O + (size_t)M * 1536, 256, 0, 1 << 20, 0, -1, 0}, ODZ },
    { {WS_DEC, 2048, 4, 8, (unsigned long long)M * 2048, 14, 0}, {WS_AA, 2048, 3, 8, (unsigned long long)M * 2048, 17, 0}, {WS_GG, 2048, 0, 1 << 20, 0, -1, 0}, ODZ, ODZ, ODZ, ODZ, ODZ },
    { {WS_DEC, 2048, 4, 8, (unsigned long long)M * 2048, 14, 4096}, {WS_AA, 2048, 3, 8, (unsigned long long)M * 2048, 17, 4096}, {WS_GG, 2048, 0, 1 << 20, 0, -1, 0},
      {WS_VG, 2048, 3, 1 << 20, 0, 28, 0}, ODZ, ODZ, ODZ, ODZ },
    { {WS_QKV, 6144, 0, 1 << 20, 0, -1, 0}, ODZ, ODZ, ODZ, ODZ, ODZ, ODZ, ODZ },
    { {WS_QKV, 3072, 0, 1 << 20, 0, -1, 0}, ODZ, ODZ, ODZ, ODZ, ODZ, ODZ, ODZ },
    { {WS_QKV, 11264, 0, 1 << 20, 0, -1, 0}, ODZ, ODZ, ODZ, ODZ, ODZ, ODZ, ODZ },
};

struct Args { const float* in[40]; float* out; unsigned char* ws; int ph_lo, ph_hi; };

struct EpiGen {
    static constexpr bool PERM = true;
    unsigned char* ws; const OutDesc* od; const float* const* in;
    __device__ __forceinline__ void operator()(const f32x4 (&acc)[2][2][4][2], const pg8::Unit& u, int wr, int wc, int fr, int fq) const {
        const OutDesc* d = od + u.sub;
        const int ldc = d->ldc, mode = d->mode, nsplit = d->nsplit;
        const int sp = u.ln / nsplit, lnl = u.ln - sp * nsplit;
        const int row0 = u.lm * 256 + wr * 64 + fr, col0 = lnl * 256 + wc * 32 + 8 * fq, bcol0 = u.ln * 256 + wc * 32 + 8 * fq;
        unsigned char* base = ws + d->off;
        const size_t esplit = (size_t)sp * d->split_stride;
        const float* bias = (d->bias_in >= 0) ? (in[d->bias_in] + d->bias_off) : nullptr;
        f32x4 bv[2][2];
#pragma unroll
        for (int bj = 0; bj < 2; ++bj)
#pragma unroll
            for (int n = 0; n < 2; ++n) bv[bj][n] = bias ? *(const f32x4*)(bias + bcol0 + bj * 128 + 4 * n) : (f32x4){0.f, 0.f, 0.f, 0.f};
#pragma unroll
        for (int ai = 0; ai < 2; ++ai)
#pragma unroll
            for (int m = 0; m < 4; ++m) {
                const size_t eoff = esplit + (size_t)(row0 + ai * 128 + m * 16) * ldc + col0;
#pragma unroll
                for (int bj = 0; bj < 2; ++bj) {
                    f32x4 v0 = acc[ai][bj][m][0] + bv[bj][0], v1 = acc[ai][bj][m][1] + bv[bj][1];
                    if (mode == 1) {
#pragma unroll
                        for (int j = 0; j < 4; ++j) { v0[j] = 1.f - 2.f * __builtin_amdgcn_rcpf(1.f + __expf(2.f * v0[j])); v1[j] = 1.f - 2.f * __builtin_amdgcn_rcpf(1.f + __expf(2.f * v1[j])); }
                    } else if (mode == 2 || mode == 3) {
#pragma unroll
                        for (int j = 0; j < 4; ++j) { v0[j] = sigmoidf_(v0[j]); v1[j] = sigmoidf_(v1[j]); }
                    } else if (mode == 4) {
#pragma unroll
                        for (int j = 0; j < 4; ++j) { v0[j] = __expf(-0.6065306597f * sigmoidf_(v0[j])); v1[j] = __expf(-0.6065306597f * sigmoidf_(v1[j])); }
                    }
                    if (mode == 4) {
                        typedef _Float16 h2 __attribute__((ext_vector_type(2)));
                        pg8::u32x4 w;
                        w.x = __builtin_bit_cast(unsigned, (h2){(_Float16)(1.f - v0[0]), (_Float16)(1.f - v0[1])}); w.y = __builtin_bit_cast(unsigned, (h2){(_Float16)(1.f - v0[2]), (_Float16)(1.f - v0[3])});
                        w.z = __builtin_bit_cast(unsigned, (h2){(_Float16)(1.f - v1[0]), (_Float16)(1.f - v1[1])}); w.w = __builtin_bit_cast(unsigned, (h2){(_Float16)(1.f - v1[2]), (_Float16)(1.f - v1[3])});
                        *(pg8::u32x4*)((bf16*)base + eoff + bj * 128) = w;
                    } else {
                        pg8::u32x4 w; w.x = cvt_pk_bf16(v0[0], v0[1]); w.y = cvt_pk_bf16(v0[2], v0[3]); w.z = cvt_pk_bf16(v1[0], v1[1]); w.w = cvt_pk_bf16(v1[2], v1[3]);
                        *(pg8::u32x4*)((bf16*)base + eoff + bj * 128) = w;
                    }
                }
            }
    }
};
struct EpiRes {
    static constexpr bool PERM = true;
    bf16* X; const float* gate3; float* outp; float* part; const float* xin;
    __device__ __forceinline__ void operator()(const f32x4 (&acc)[2][2][4][2], const pg8::Unit& u, int wr, int wc, int fr, int fq) const {
        const int b = u.lm / 17, tb = u.lm - b * 17; const int isctx = (tb == 16);
        const float* gate = gate3 + (size_t)(isctx ? 2 : b) * (6 * D);
        const int row0 = u.lm * 256 + wr * 64 + fr, col0 = u.ln * 256 + wc * 32 + 8 * fq;
        if (u.kpart >= 0) {
            float* pb = part + ((size_t)u.kpart * 512 + (size_t)b * 256 + wr * 64 + fr) * D + col0;
#pragma unroll
            for (int ai = 0; ai < 2; ++ai)
#pragma unroll
                for (int m = 0; m < 4; ++m)
#pragma unroll
                    for (int bj = 0; bj < 2; ++bj) { float* p = pb + (size_t)(ai * 128 + m * 16) * D + bj * 128; *(f32x4*)p = acc[ai][bj][m][0]; *(f32x4*)(p + 4) = acc[ai][bj][m][1]; }
            return;
        }
        if (outp && isctx) return;
        const long radj = (long)(b * 16 + tb) * 256 - (long)u.lm * 256;
        f32x4 gv[2][2];
#pragma unroll
        for (int bj = 0; bj < 2; ++bj)
#pragma unroll
            for (int n = 0; n < 2; ++n) gv[bj][n] = *(const f32x4*)(gate + col0 + bj * 128 + 4 * n);
#pragma unroll
        for (int ai = 0; ai < 2; ++ai)
#pragma unroll
            for (int m = 0; m < 4; ++m) {
                const int row = row0 + ai * 128 + m * 16;
                bf16* xb = X + (size_t)row * D + col0;
#pragma unroll
                for (int bj = 0; bj < 2; ++bj) {
                    f32x4 x0, x1;
                    if (xin) { const float* xp = xin + (size_t)(row + radj) * D + col0 + bj * 128; x0 = *(const f32x4*)xp; x1 = *(const f32x4*)(xp + 4); }
                    else { const pg8::u32x4 t = *(const pg8::u32x4*)(xb + bj * 128); x0 = (f32x4){bflo(t.x), bfhi(t.x), bflo(t.y), bfhi(t.y)}; x1 = (f32x4){bflo(t.z), bfhi(t.z), bflo(t.w), bfhi(t.w)}; }
                    const f32x4 y0 = x0 + gv[bj][0] * acc[ai][bj][m][0], y1 = x1 + gv[bj][1] * acc[ai][bj][m][1];
                    if (outp) { float* op = outp + (size_t)(row + radj) * D + col0 + bj * 128; *(f32x4*)op = y0; *(f32x4*)(op + 4) = y1; }
                    else { pg8::u32x4 w; w.x = cvt_pk_bf16(y0.x, y0.y); w.y = cvt_pk_bf16(y0.z, y0.w); w.z = cvt_pk_bf16(y1.x, y1.y); w.w = cvt_pk_bf16(y1.z, y1.w); *(pg8::u32x4*)(xb + bj * 128) = w; }
                }
            }
    }
};


struct EpiQKV {
    static constexpr bool PERM = true;
    bf16* O; int ldc, nqk, nq; const float* qg; const float* kg; int rope; LAS float* part;
    __device__ __forceinline__ void operator()(const f32x4 (&acc)[2][2][4][2], const pg8::Unit& u, int wr, int wc, int fr_in, int fq_in) const {
        int fr = fr_in, fq = fq_in; asm volatile("" : "+v"(fr), "+v"(fq));
        const bool isqk = u.ln < nqk;
        if (isqk) {
#pragma unroll
            for (int ai = 0; ai < 2; ++ai)
#pragma unroll
                for (int m = 0; m < 4; ++m)
#pragma unroll
                    for (int bj = 0; bj < 2; ++bj) {
                        const f32x4 a = acc[ai][bj][m][0], b = acc[ai][bj][m][1];
                        float s = ((a.x * a.x + a.y * a.y) + (a.z * a.z + a.w * a.w)) + ((b.x * b.x + b.y * b.y) + (b.z * b.z + b.w * b.w));
                        { const auto x = __builtin_amdgcn_permlane16_swap(__float_as_uint(s), __float_as_uint(s), false, false); s = __uint_as_float(x[0]) + __uint_as_float(x[1]); }
                        { const auto x = __builtin_amdgcn_permlane32_swap(__float_as_uint(s), __float_as_uint(s), false, false); s = __uint_as_float(x[0]) + __uint_as_float(x[1]); }
                        if (fq == 0) part[((ai * 128 + wr * 64 + m * 16 + fr) * 2 + bj) * 4 + wc] = s;
                    }
        }
        asm volatile("s_waitcnt lgkmcnt(0)" ::: "memory"); __builtin_amdgcn_s_barrier(); asm volatile("" ::: "memory");
        const float* g = (u.ln < nq) ? qg : kg;
        const int cc0 = 32 * (wc & 1) + 8 * fq;
        const float* gA = rope ? (g + 64 * (wc >> 1) + (cc0 >> 1)) : (g + 32 * wc + 8 * fq);
        const float* gB = rope ? (gA + 32) : (gA + 4);
#pragma unroll
        for (int ai = 0; ai < 2; ++ai)
#pragma unroll
            for (int m = 0; m < 4; ++m) {
                const int rl = ai * 128 + wr * 64 + m * 16 + fr, row = u.lm * 256 + rl;
                const int tb = row % SB; const bool lat = tb < SEQ;
                const float ps = (float)((wc >> 1) ? (tb & 63) : (tb >> 6));
#pragma unroll
                for (int bj = 0; bj < 2; ++bj) {
                    float x[8]; { const f32x4 t0 = acc[ai][bj][m][0], t1 = acc[ai][bj][m][1]; x[0] = t0.x; x[1] = t0.y; x[2] = t0.z; x[3] = t0.w; x[4] = t1.x; x[5] = t1.y; x[6] = t1.z; x[7] = t1.w; }
                    if (isqk) {
                        const f32x4 p4 = *(const LAS f32x4*)(part + (rl * 2 + bj) * 4);
                        const float rstd = rsqrtf(((p4.x + p4.y) + (p4.z + p4.w)) * (1.f / 128.f) + NORM_EPS);
                        const f32x4 ga = *(const f32x4*)gA, gb = *(const f32x4*)gB;
                        if (rope) { x[0] *= rstd * ga.x; x[1] *= rstd * gb.x; x[2] *= rstd * ga.y; x[3] *= rstd * gb.y; x[4] *= rstd * ga.z; x[5] *= rstd * gb.z; x[6] *= rstd * ga.w; x[7] *= rstd * gb.w; }
                        else { x[0] *= rstd * ga.x; x[1] *= rstd * ga.y; x[2] *= rstd * ga.z; x[3] *= rstd * ga.w; x[4] *= rstd * gb.x; x[5] *= rstd * gb.y; x[6] *= rstd * gb.z; x[7] *= rstd * gb.w; }
                        if (rope && lat) {
#pragma unroll
                            for (int pq = 0; pq < 4; ++pq) { const float ang = ps * __builtin_amdgcn_exp2f(-(float)((cc0 >> 1) + pq) * (13.287712379549449f / 32.f)), cs = __cosf(ang), sn = __sinf(ang), x1 = x[2 * pq], x2 = x[2 * pq + 1];
                                x[2 * pq] = x1 * cs - x2 * sn; x[2 * pq + 1] = x1 * sn + x2 * cs; }
                        }
                    }
                    pg8::u32x4 w; w.x = cvt_pk_bf16_v(x[0], x[1]); w.y = cvt_pk_bf16_v(x[2], x[3]); w.z = cvt_pk_bf16_v(x[4], x[5]); w.w = cvt_pk_bf16_v(x[6], x[7]);
                    *(pg8::u32x4*)(O + (size_t)row * ldc + u.ln * 256 + bj * 128 + wc * 32 + 8 * fq) = w;
                }
                asm volatile("" ::: "memory");
            }
    }
};

template <int CTRL, bool BC> __device__ __forceinline__ float dppu(float old, float v) { return __builtin_bit_cast(float, __builtin_amdgcn_update_dpp(__builtin_bit_cast(int, old), __builtin_bit_cast(int, v), CTRL, 0xF, 0xF, BC)); }
struct EpiUp {
    static constexpr bool PERM = true;
    bf16* ACT; float* HALO; const float* cw; const float* cb;
    __device__ __forceinline__ void operator()(const f32x4 (&acc)[2][2][4][2], const pg8::Unit& u, int wr, int wc, int fr, int fq) const {
        const int f0 = u.ln * 128 + wc * 32 + 8 * fq;
#pragma unroll
        for (int ai = 0; ai < 2; ++ai) {
            const int rowbase = u.lm * 256 + ai * 128 + wr * 64, grp = rowbase >> 6;
            if (fr < 2 || fr >= 14) {
                const int m = fr < 2 ? 0 : 3; float* hp = HALO + (size_t)(grp * 4 + (fr < 2 ? fr : fr - 12)) * DFF2 + f0;
#pragma unroll
                for (int bj = 0; bj < 2; ++bj)
#pragma unroll
                    for (int n = 0; n < 2; ++n) *(f32x4*)(hp + bj * DFF + 4 * n) = fr < 2 ? acc[ai][bj][0][n] : acc[ai][bj][3][n];
                (void)m;
            }
            unsigned ow[4][4];
#pragma unroll
            for (int n = 0; n < 2; ++n) {
                const int fc = f0 + 4 * n;
                const f32x4 g0 = *(const f32x4*)(cw + fc), g1 = *(const f32x4*)(cw + DFF2 + fc), g2 = *(const f32x4*)(cw + 2 * DFF2 + fc), gb = *(const f32x4*)(cb + fc);
                const f32x4 v0 = *(const f32x4*)(cw + DFF + fc), v1 = *(const f32x4*)(cw + DFF2 + DFF + fc), v2 = *(const f32x4*)(cw + 2 * DFF2 + DFF + fc), vb = *(const f32x4*)(cb + DFF + fc);
                float o[4][4];
#pragma unroll
                for (int e = 0; e < 4; ++e) {
                    float G[4], V[4];
#pragma unroll
                    for (int m = 0; m < 4; ++m) {
                        {   const float c = acc[ai][0][m][n][e];
                            const float pv = (m > 0) ? dppu<0x111, false>(dppu<0x121, true>(0.f, acc[ai][0][m > 0 ? m - 1 : 0][n][e]), c) : dppu<0x111, true>(0.f, c);
                            const float nx = (m < 3) ? dppu<0x101, false>(dppu<0x12F, true>(0.f, acc[ai][0][m < 3 ? m + 1 : 3][n][e]), c) : dppu<0x101, true>(0.f, c);
                            G[m] = gb[e] + g0[e] * pv + g1[e] * c + g2[e] * nx; }
                        {   const float c = acc[ai][1][m][n][e];
                            const float pv = (m > 0) ? dppu<0x111, false>(dppu<0x121, true>(0.f, acc[ai][1][m > 0 ? m - 1 : 0][n][e]), c) : dppu<0x111, true>(0.f, c);
                            const float nx = (m < 3) ? dppu<0x101, false>(dppu<0x12F, true>(0.f, acc[ai][1][m < 3 ? m + 1 : 3][n][e]), c) : dppu<0x101, true>(0.f, c);
                            V[m] = vb[e] + v0[e] * pv + v1[e] * c + v2[e] * nx; }
                        o[m][e] = G[m] * V[m] * __builtin_amdgcn_rcpf(1.f + __expf(-G[m]));
                    }
                }
#pragma unroll
                for (int m = 0; m < 4; ++m) { ow[m][2 * n] = cvt_pk_bf16(o[m][0], o[m][1]); ow[m][2 * n + 1] = cvt_pk_bf16(o[m][2], o[m][3]); }
            }
#pragma unroll
            for (int m = 0; m < 4; ++m) { v4u w; w.x = ow[m][0]; w.y = ow[m][1]; w.z = ow[m][2]; w.w = ow[m][3];
                *(v4u*)(ACT + (size_t)(rowbase + 16 * m + fr) * DFF + f0) = w; }
        }
    }
};

namespace att {
using s16x4  = __attribute__((ext_vector_type(4))) short;
using f32x16 = __attribute__((ext_vector_type(16))) float;
using u32x4  = __attribute__((ext_vector_type(4))) unsigned;
constexpr int KVBLK = 64, QBLK = 32, NW = 8;
constexpr float SCALE = 0.088388347648318440f;
constexpr float THR = 8.f;
constexpr float NEGBIG = -1e30f;
constexpr size_t SHM_V = KVBLK * HD * 2, SHM_K = KVBLK * HD * 2, SHM_ATTN = 2 * SHM_V + 2 * SHM_K + NW * 64 * 4;
#define KSWZ(row, colB) ((row) * 256 + ((colB) ^ (((row) & 7) << 4)))
#define SBAR() __builtin_amdgcn_sched_barrier(0)
__device__ __forceinline__ int crow(int r, int hi) { return (r & 3) + 8 * (r >> 2) + 4 * hi; }
__device__ __forceinline__ unsigned cvtpk(float lo, float hi) { unsigned r; asm volatile("v_cvt_pk_bf16_f32 %0, %1, %2" : "=v"(r) : "v"(lo), "v"(hi)); return r; }

__device__ __forceinline__ void partialSM(f32x16& p0, f32x16& p1, float& m_reg, float& mn, float& alpha) {
  constexpr float C = SCALE * 1.4426950408889634f;
  float pmax = p0[0]; for (int r = 1; r < 16; ++r) pmax = fmaxf(pmax, p0[r]); for (int r = 0; r < 16; ++r) pmax = fmaxf(pmax, p1[r]);
  { auto rr = __builtin_amdgcn_permlane32_swap(__float_as_uint(pmax), __float_as_uint(pmax), false, false);
    pmax = fmaxf(__uint_as_float(rr[0]), __uint_as_float(rr[1])); }
  if (__builtin_expect(__all(pmax - m_reg <= THR / SCALE), 1)) { mn = m_reg; alpha = 1.f; }
  else { mn = fmaxf(m_reg, pmax); alpha = __builtin_amdgcn_exp2f((m_reg - mn) * C); m_reg = mn; }
  float mnC = -mn * C;
  for (int r = 0; r < 16; ++r) p0[r] = fmaf(p0[r], C, mnC); for (int r = 0; r < 16; ++r) p1[r] = fmaf(p1[r], C, mnC);
  for (int r = 0; r < 16; ++r) p0[r] = __builtin_amdgcn_exp2f(p0[r]);
}
__device__ __forceinline__ void finishSM(f32x16& p0, f32x16& p1, float alpha, float& l_reg, bf16x8& pa0, bf16x8& pa1, bf16x8& pa2, bf16x8& pa3) {
  for (int r = 0; r < 16; ++r) p1[r] = __builtin_amdgcn_exp2f(p1[r]);
  float ps = 0; for (int r = 0; r < 16; ++r) ps += p0[r]; for (int r = 0; r < 16; ++r) ps += p1[r];
  { auto rr = __builtin_amdgcn_permlane32_swap(__float_as_uint(ps), __float_as_uint(ps), false, false);
    ps = __uint_as_float(rr[0]) + __uint_as_float(rr[1]); }
  l_reg = l_reg * alpha + ps;
#define PK4(P, BASE, OUT) do { unsigned a0 = cvtpk(P[BASE + 0], P[BASE + 1]), a1 = cvtpk(P[BASE + 2], P[BASE + 3]);   \
    unsigned b0 = cvtpk(P[BASE + 4], P[BASE + 5]), b1 = cvtpk(P[BASE + 6], P[BASE + 7]);                              \
    auto r0 = __builtin_amdgcn_permlane32_swap(a0, b0, false, false); auto r1 = __builtin_amdgcn_permlane32_swap(a1, b1, false, false); \
    u32x4 w = {r0[0], r1[0], r0[1], r1[1]}; OUT = *reinterpret_cast<bf16x8*>(&w); } while (0)
  PK4(p0, 0, pa0); PK4(p0, 8, pa1); PK4(p1, 0, pa2); PK4(p1, 8, pa3);
#undef PK4
}
template <unsigned M0, unsigned M1>
__device__ __forceinline__ void partialSM_m(f32x16& p0, f32x16& p1, float& m_reg, float& mn, float& alpha) {
  constexpr float C = SCALE * 1.4426950408889634f;
  float pmax = NEGBIG;
#pragma unroll
  for (int r = 0; r < 16; ++r) { pmax = fmaxf(pmax, ((M0 >> r) & 1u) ? p0[r] : NEGBIG); pmax = fmaxf(pmax, ((M1 >> r) & 1u) ? p1[r] : NEGBIG); }
  { auto rr = __builtin_amdgcn_permlane32_swap(__float_as_uint(pmax), __float_as_uint(pmax), false, false);
    pmax = fmaxf(__uint_as_float(rr[0]), __uint_as_float(rr[1])); }
  if (__builtin_expect(__all(pmax - m_reg <= THR / SCALE), 1)) { mn = m_reg; alpha = 1.f; }
  else { mn = fmaxf(m_reg, pmax); alpha = __builtin_amdgcn_exp2f((m_reg - mn) * C); m_reg = mn; }
  const float mnC = -mn * C;
#pragma unroll
  for (int r = 0; r < 16; ++r) { p0[r] = ((M0 >> r) & 1u) ? __builtin_amdgcn_exp2f(fmaf(p0[r], C, mnC)) : 0.f; p1[r] = ((M1 >> r) & 1u) ? fmaf(p1[r], C, mnC) : 0.f; }
}
template <unsigned M0, unsigned M1>
__device__ __forceinline__ void finishSM_m(f32x16& p0, f32x16& p1, float alpha, float& l_reg, bf16x8& pa0, bf16x8& pa1, bf16x8& pa2, bf16x8& pa3) {
  float ps = 0;
#pragma unroll
  for (int r = 0; r < 16; ++r) { p1[r] = ((M1 >> r) & 1u) ? __builtin_amdgcn_exp2f(p1[r]) : 0.f; ps += p1[r]; ps += p0[r]; }
  { auto rr = __builtin_amdgcn_permlane32_swap(__float_as_uint(ps), __float_as_uint(ps), false, false);
    ps = __uint_as_float(rr[0]) + __uint_as_float(rr[1]); }
  l_reg = l_reg * alpha + ps;
#define PK4(P, BASE, OUT) do { unsigned a0 = cvtpk(P[BASE + 0], P[BASE + 1]), a1 = cvtpk(P[BASE + 2], P[BASE + 3]);   \
    unsigned b0 = cvtpk(P[BASE + 4], P[BASE + 5]), b1 = cvtpk(P[BASE + 6], P[BASE + 7]);                              \
    auto r0 = __builtin_amdgcn_permlane32_swap(a0, b0, false, false); auto r1 = __builtin_amdgcn_permlane32_swap(a1, b1, false, false); \
    u32x4 w = {r0[0], r1[0], r0[1], r1[1]}; OUT = *reinterpret_cast<bf16x8*>(&w); } while (0)
  PK4(p0, 0, pa0); PK4(p0, 8, pa1); PK4(p1, 0, pa2); PK4(p1, 8, pa3);
#undef PK4
}
__device__ __forceinline__ void qkt(f32x16& p0, f32x16& p1, const bf16* Ks, const bf16x8* qr, int r32, int hi) {
  p0 = f32x16{}; p1 = f32x16{};
  for (int d0 = 0; d0 < 8; ++d0) { int cb = (d0 * 16 + hi * 8) * 2;
    bf16x8 b0 = *reinterpret_cast<const bf16x8*>((const char*)Ks + KSWZ(r32, cb));
    bf16x8 b1 = *reinterpret_cast<const bf16x8*>((const char*)Ks + KSWZ(32 + r32, cb));
    p0 = __builtin_amdgcn_mfma_f32_32x32x16_bf16(b0, qr[d0], p0, 0, 0, 0);
    p1 = __builtin_amdgcn_mfma_f32_32x32x16_bf16(b1, qr[d0], p1, 0, 0, 0); }
}
__device__ __forceinline__ int v_st(int k, int c) { const int kk = (k & ~0xC) | ((k & 4) << 1) | ((k & 8) >> 1); return ((kk >> 3) * 4 + (c >> 5)) * 512 + ((kk & 7) * 32 + (c & 31)) * 2; }
__device__ __forceinline__ int v_rd_base(int lane) { return ((lane & 3) << 3) | (((lane >> 2) & 3) << 6) | (((lane >> 4) & 1) << 5) | (((lane >> 5) & 1) << 8); }
constexpr int v_rd_off(int d0, int ks, int half) { return d0 * 512 + ks * 4096 + half * 2048; }
template <int OFF> __device__ __forceinline__ s16x4 tr_read(int vb) {
  s16x4 r; asm volatile("ds_read_b64_tr_b16 %0, %1 offset:%2" : "=&v"(r) : "v"(vb), "i"(OFF) : "memory"); return r;
}
template <int D0, int SKIP = 0> __device__ __forceinline__ void pv_one(f32x16& od, int vb, bf16x8 pa0, bf16x8 pa1, bf16x8 pa2, bf16x8 pa3) {
  s16x4 l0 = {}, h0 = {}, l3 = {}, h3 = {};
  if (SKIP != 2) { l0 = tr_read<v_rd_off(D0, 0, 0)>(vb); h0 = tr_read<v_rd_off(D0, 0, 1)>(vb); }
  const s16x4 l1 = tr_read<v_rd_off(D0, 1, 0)>(vb), h1 = tr_read<v_rd_off(D0, 1, 1)>(vb);
  const s16x4 l2 = tr_read<v_rd_off(D0, 2, 0)>(vb), h2 = tr_read<v_rd_off(D0, 2, 1)>(vb);
  if (SKIP != 1) { l3 = tr_read<v_rd_off(D0, 3, 0)>(vb); h3 = tr_read<v_rd_off(D0, 3, 1)>(vb); }
  asm volatile("s_waitcnt lgkmcnt(0)" ::: "memory"); SBAR();
#define PK(L, H) (bf16x8){L[0], L[1], L[2], L[3], H[0], H[1], H[2], H[3]}
  if (SKIP != 2) od = __builtin_amdgcn_mfma_f32_32x32x16_bf16(pa0, PK(l0, h0), od, 0, 0, 0);
  od = __builtin_amdgcn_mfma_f32_32x32x16_bf16(pa1, PK(l1, h1), od, 0, 0, 0);
  od = __builtin_amdgcn_mfma_f32_32x32x16_bf16(pa2, PK(l2, h2), od, 0, 0, 0);
  if (SKIP != 1) od = __builtin_amdgcn_mfma_f32_32x32x16_bf16(pa3, PK(l3, h3), od, 0, 0, 0);
#undef PK
}
template <int SKIP = 0>
__device__ __forceinline__ void pv_d0(f32x16* o, int vb, bf16x8 pa0, bf16x8 pa1, bf16x8 pa2, bf16x8 pa3) {
  pv_one<0, SKIP>(o[0], vb, pa0, pa1, pa2, pa3); pv_one<1, SKIP>(o[1], vb, pa0, pa1, pa2, pa3); pv_one<2, SKIP>(o[2], vb, pa0, pa1, pa2, pa3); pv_one<3, SKIP>(o[3], vb, pa0, pa1, pa2, pa3);
}
struct NaInfo { int r0, rs_lo; const float* tab; };
template <unsigned M0 = 0xFFFFu, unsigned M1 = 0xFFFFu>
__device__ __forceinline__ void na_mask(f32x16& p0, f32x16& p1, int j, const NaInfo& na, int wid, int r32, int hi) {
  if (j < 4) return;
  const int rq = na.r0 + (wid >> 1); int rsq = rq - 4; rsq = rsq < 0 ? 0 : (rsq > 56 ? 56 : rsq);
  const int kr = na.rs_lo + (j - 4);
  const bool valid = (kr >= rsq) && (kr < rsq + 8);
  if (!valid) {
#pragma unroll
    for (int r = 0; r < 16; ++r) { p0[r] = NEGBIG; p1[r] = NEGBIG; }
    return;
  }
  const int dr = kr - rq + 7;
  const int c = (wid & 1) * 32 + r32; int cs = c - 8; cs = cs < 0 ? 0 : (cs > 48 ? 48 : cs);
  const float* tb = na.tab + 64 + dr * 31 - c + 15 + 4 * hi;
  const int t0 = 4 * hi - cs;
#pragma unroll
  for (int r = 0; r < 16; ++r) {
    const int o = (r & 3) + 8 * (r >> 2);
    { const bool in = (unsigned)(t0 + o) < 16u; const float bsv = tb[o]; p0[r] = ((M0 >> r) & 1u) ? (in ? p0[r] + bsv : NEGBIG) : NEGBIG; }
    { const bool in = (unsigned)(t0 + o + 32) < 16u; const float bsv = tb[o + 32]; p1[r] = ((M1 >> r) & 1u) ? (in ? p1[r] + bsv : NEGBIG) : NEGBIG; }
  }
}
template <int LDQ, int LDK, int LDO, bool NA>
__device__ __forceinline__ void attn_unit(const bf16* __restrict__ Qb, const bf16* __restrict__ Kh, const bf16* __restrict__ Vh, bf16* __restrict__ Ob,
                                          int NT, int nfirst, int first0, int second0, char* lds, const NaInfo na) {
  const int tid = ltid(), wid = tid >> 6, lane = tid & 63, r32 = lane & 31, hi = lane >> 5;
  bf16* V_lds = (bf16*)lds; bf16* K_lds = (bf16*)(lds + 2 * SHM_V);
  float* ws = (float*)(lds + 2 * SHM_V + 2 * SHM_K) + wid * 64; float* li_l = ws; float* al_l = ws + 32;
  float m_reg = -1e30f, l_reg = 0; f32x16 o[4] = {}; bf16x8 qr[8];
  const bf16* Qw = Qb + (long)(wid * QBLK + r32) * LDQ + hi * 8;
#pragma unroll
  for (int d0 = 0; d0 < 8; ++d0) qr[d0] = *reinterpret_cast<const bf16x8*>(Qw + d0 * 16);
  const int sr = tid >> 4, sc = (tid & 15) * 8, vst0 = v_st(sr, sc), vst1 = v_st(32 + sr, sc);
  const int vb0 = (int)(uintptr_t)V_lds + v_rd_base(lane);
  struct { bf16x8 vs0, vs1, ks0, ks1; } sr_[2];
#define KROW(j) ((j) < nfirst ? first0 + 64 * (j) : second0 + 64 * ((j) - nfirst))
#define SLOAD(i, jt) do { const long k0_ = KROW(jt); sr_[i].vs0 = *reinterpret_cast<const bf16x8*>(&Vh[(k0_ + sr) * LDK + sc]); sr_[i].vs1 = *reinterpret_cast<const bf16x8*>(&Vh[(k0_ + 32 + sr) * LDK + sc]); \
    sr_[i].ks0 = *reinterpret_cast<const bf16x8*>(&Kh[(k0_ + sr) * LDK + sc]); sr_[i].ks1 = *reinterpret_cast<const bf16x8*>(&Kh[(k0_ + 32 + sr) * LDK + sc]); } while (0)
#define SWRITE(b, i) do { *(bf16x8*)((char*)V_lds + (b) * SHM_V + vst0) = sr_[i].vs0;          \
    *(bf16x8*)((char*)V_lds + (b) * SHM_V + vst1) = sr_[i].vs1; int kc = sc * 2;               \
    *(bf16x8*)((char*)K_lds + (b) * SHM_K + KSWZ(sr, kc)) = sr_[i].ks0;                       \
    *(bf16x8*)((char*)K_lds + (b) * SHM_K + KSWZ(32 + sr, kc)) = sr_[i].ks1; } while (0)
#define SWAIT() asm volatile("s_waitcnt vmcnt(4)" ::: "memory")
#define RESC(a) do { if (__any((a) < 1.f)) { if (hi == 0) al_l[r32] = (a); asm volatile("s_waitcnt lgkmcnt(0)" ::: "memory"); \
    for (int d = 0; d < 4; ++d) for (int r = 0; r < 16; ++r) o[d][r] *= al_l[crow(r, hi)]; } } while (0)
  f32x16 pA0, pA1, pB0, pB1; float mnA, mnB, alA, alB; bf16x8 pa0, pa1, pa2, pa3;
  constexpr int SE = 0, SO = 1;
  SLOAD(SE, 0); asm volatile("s_waitcnt vmcnt(0)" ::: "memory"); SWRITE(0, SE); __syncthreads();
  qkt(pA0, pA1, K_lds, qr, r32, hi); if (NA) na_mask(pA0, pA1, 0, na, wid, r32, hi); partialSM(pA0, pA1, m_reg, mnA, alA);
  SLOAD(SO, 1); if (2 < NT) SLOAD(SE, 2);
  SWAIT(); SWRITE(1, SO); __syncthreads();
  for (int j = 1; j + 1 < NT; j += 2) {
    SBAR(); qkt(pB0, pB1, (bf16*)((char*)K_lds + SHM_K), qr, r32, hi); if (NA) na_mask(pB0, pB1, j, na, wid, r32, hi);
    finishSM(pA0, pA1, alA, l_reg, pa0, pa1, pa2, pa3); SBAR();
    SLOAD(SO, (j + 2)); SBAR();
    pv_d0(o, vb0, pa0, pa1, pa2, pa3); partialSM(pB0, pB1, m_reg, mnB, alB);
    __syncthreads(); SWAIT(); SWRITE(0, SE);
    RESC(alB); __syncthreads();
    SBAR(); qkt(pA0, pA1, K_lds, qr, r32, hi); if (NA) na_mask(pA0, pA1, j + 1, na, wid, r32, hi);
    finishSM(pB0, pB1, alB, l_reg, pa0, pa1, pa2, pa3); SBAR();
    if (j + 3 < NT) SLOAD(SE, (j + 3)); SBAR();
    pv_d0(o, vb0 + (int)SHM_V, pa0, pa1, pa2, pa3); partialSM(pA0, pA1, m_reg, mnA, alA);
    __syncthreads(); SWAIT(); SWRITE(1, SO);
    RESC(alA); __syncthreads();
  }
  SBAR(); qkt(pB0, pB1, (bf16*)((char*)K_lds + SHM_K), qr, r32, hi); if (NA) na_mask(pB0, pB1, NT - 1, na, wid, r32, hi);
  finishSM(pA0, pA1, alA, l_reg, pa0, pa1, pa2, pa3); SBAR();
  pv_d0(o, vb0, pa0, pa1, pa2, pa3); partialSM(pB0, pB1, m_reg, mnB, alB);
  __syncthreads(); RESC(alB);
  finishSM(pB0, pB1, alB, l_reg, pa0, pa1, pa2, pa3); SBAR();
  pv_d0(o, vb0 + (int)SHM_V, pa0, pa1, pa2, pa3);
  if (hi == 0) li_l[r32] = l_reg; asm volatile("s_waitcnt lgkmcnt(0)" ::: "memory");
  float rli[16];
#pragma unroll
  for (int r = 0; r < 16; ++r) rli[r] = __builtin_amdgcn_rcpf(li_l[crow(r, hi)]);
  bf16* Ow = Ob + (long)(wid * QBLK) * LDO;
#pragma unroll
  for (int r = 0; r < 16; ++r) { int orow = crow(r, hi);
#pragma unroll
    for (int d0 = 0; d0 < 4; ++d0) Ow[(long)orow * LDO + d0 * 32 + r32] = (bf16)(cvtpk(o[d0][r] * rli[r], 0.f) & 0xffffu); }
  __syncthreads();
#undef KROW
#undef SLOAD
#undef SWRITE
#undef SWAIT
#undef RESC
}

template <int LDQ, int LDK, int LDO, bool NA>
__device__ __forceinline__ void attn_unit_simple(const bf16* __restrict__ Qb, const bf16* __restrict__ Kh, const bf16* __restrict__ Vh, bf16* __restrict__ Ob,
                                                 int NT, int nfirst, int first0, int second0, char* lds, const NaInfo na) {
  const int tid = ltid(), wid = tid >> 6, lane = tid & 63, r32 = lane & 31, hi = lane >> 5;
  bf16* V_lds = (bf16*)lds; bf16* K_lds = (bf16*)(lds + 2 * SHM_V);
  float* ws = (float*)(lds + 2 * SHM_V + 2 * SHM_K) + wid * 64; float* li_l = ws; float* al_l = ws + 32;
  float m_reg = -1e30f, l_reg = 0; f32x16 o[4] = {}; bf16x8 qr[8];
  const bf16* Qw = Qb + (long)(wid * QBLK + r32) * LDQ + hi * 8;
#pragma unroll
  for (int d0 = 0; d0 < 8; ++d0) qr[d0] = *reinterpret_cast<const bf16x8*>(Qw + d0 * 16);
  const int sr = tid >> 4, sc = (tid & 15) * 8, vst0 = v_st(sr, sc), vst1 = v_st(32 + sr, sc);
  const int vb0 = (int)(uintptr_t)V_lds + v_rd_base(lane);
  bf16x8 vs0, vs1, ks0, ks1;
#define KROW(j) ((j) < nfirst ? first0 + 64 * (j) : second0 + 64 * ((j) - nfirst))
#define SLOAD1(jt) do { const long k0_ = KROW(jt); vs0 = *reinterpret_cast<const bf16x8*>(&Vh[(k0_ + sr) * LDK + sc]); vs1 = *reinterpret_cast<const bf16x8*>(&Vh[(k0_ + 32 + sr) * LDK + sc]); \
    ks0 = *reinterpret_cast<const bf16x8*>(&Kh[(k0_ + sr) * LDK + sc]); ks1 = *reinterpret_cast<const bf16x8*>(&Kh[(k0_ + 32 + sr) * LDK + sc]); } while (0)
#define SWRITE1(b) do { *(bf16x8*)((char*)V_lds + (b) * SHM_V + vst0) = vs0; *(bf16x8*)((char*)V_lds + (b) * SHM_V + vst1) = vs1; int kc = sc * 2; \
    *(bf16x8*)((char*)K_lds + (b) * SHM_K + KSWZ(sr, kc)) = ks0; *(bf16x8*)((char*)K_lds + (b) * SHM_K + KSWZ(32 + sr, kc)) = ks1; } while (0)
  SLOAD1(0); asm volatile("s_waitcnt vmcnt(0)" ::: "memory"); SWRITE1(0); __syncthreads();
  for (int j = 0; j < NT; ++j) {
    const int bsel = j & 1;
    if (j + 1 < NT) SLOAD1(j + 1);
    bool live = true;
    if (NA && j >= 4) { const int rq = na.r0 + (wid >> 1); int rsq = rq - 4; rsq = rsq < 0 ? 0 : (rsq > 56 ? 56 : rsq); const int kr = na.rs_lo + (j - 4); live = (kr >= rsq) && (kr < rsq + 8); }
    if (live) {
    f32x16 p0, p1; float mn, alpha; bf16x8 pa0, pa1, pa2, pa3;
    SBAR(); qkt(p0, p1, (bf16*)((char*)K_lds + bsel * SHM_K), qr, r32, hi);
    const int nsel = (NA && j >= 4) ? 1 + (wid & 1) : 0;
    if (nsel == 1) { na_mask<0xFFFFu, 0x000Fu>(p0, p1, j, na, wid, r32, hi); partialSM_m<0xFFFFu, 0x000Fu>(p0, p1, m_reg, mn, alpha); }
    else if (nsel == 2) { na_mask<0xF000u, 0xFFFFu>(p0, p1, j, na, wid, r32, hi); partialSM_m<0xF000u, 0xFFFFu>(p0, p1, m_reg, mn, alpha); }
    else partialSM(p0, p1, m_reg, mn, alpha);
    if (__any(alpha < 1.f)) { if (hi == 0) al_l[r32] = alpha; asm volatile("s_waitcnt lgkmcnt(0)" ::: "memory");
#pragma unroll
      for (int d = 0; d < 4; ++d)
#pragma unroll
        for (int r = 0; r < 16; ++r) o[d][r] *= al_l[crow(r, hi)]; }
    if (nsel == 1) finishSM_m<0xFFFFu, 0x000Fu>(p0, p1, alpha, l_reg, pa0, pa1, pa2, pa3);
    else if (nsel == 2) finishSM_m<0xF000u, 0xFFFFu>(p0, p1, alpha, l_reg, pa0, pa1, pa2, pa3);
    else finishSM(p0, p1, alpha, l_reg, pa0, pa1, pa2, pa3);
    SBAR();
    if (nsel == 1) pv_d0<1>(o, vb0 + bsel * (int)SHM_V, pa0, pa1, pa2, pa3);
    else if (nsel == 2) pv_d0<2>(o, vb0 + bsel * (int)SHM_V, pa0, pa1, pa2, pa3);
    else pv_d0<0>(o, vb0 + bsel * (int)SHM_V, pa0, pa1, pa2, pa3);
    }
    if (j + 1 < NT) { asm volatile("s_waitcnt vmcnt(0)" ::: "memory"); SWRITE1(bsel ^ 1); }
    __syncthreads();
  }
  if (hi == 0) li_l[r32] = l_reg; asm volatile("s_waitcnt lgkmcnt(0)" ::: "memory");
  float rli[16];
#pragma unroll
  for (int r = 0; r < 16; ++r) rli[r] = __builtin_amdgcn_rcpf(li_l[crow(r, hi)]);
  bf16* Ow = Ob + (long)(wid * QBLK) * LDO;
#pragma unroll
  for (int r = 0; r < 16; ++r) { int orow = crow(r, hi);
#pragma unroll
    for (int d0 = 0; d0 < 4; ++d0) Ow[(long)orow * LDO + d0 * 32 + r32] = (bf16)(cvtpk(o[d0][r] * rli[r], 0.f) & 0xffffu); }
  __syncthreads();
#undef KROW
#undef SLOAD1
#undef SWRITE1
}
}

constexpr int RING_OFF = 0, RING_BYTES = 131072;
constexpr int LDSCTL_OFF = RING_BYTES, MISC_OFF = LDSCTL_OFF + 320;
constexpr int LDS_BYTES = 147456;
#define RLX_AGENT __ATOMIC_RELAXED, __HIP_MEMORY_SCOPE_AGENT

#define XB_TMO      128
#define XB_XCNT(j)  (256  + 64 * (j))
#define XB_XSUB(j)  (1280 + 64 * (j))
#define XB_XGEN(j)  (2304 + 64 * (j))
#define XB_TOP      3328
#define XB_TOPGEN   3392
#define XCD_BAR_WORDS 3456
#define XB_SPIN_CAP (1u << 18)
__device__ __forceinline__ unsigned xb_ld(unsigned* p)              { return __hip_atomic_load(p, __ATOMIC_RELAXED, __HIP_MEMORY_SCOPE_AGENT); }
__device__ __forceinline__ unsigned xb_add(unsigned* p, unsigned v) { return __hip_atomic_fetch_add(p, v, __ATOMIC_RELAXED, __HIP_MEMORY_SCOPE_AGENT); }
__device__ __forceinline__ unsigned xb_xcc_id() { return (unsigned)__builtin_amdgcn_s_getreg((3 << 11) | 20) & 0xFu; }
#define XB_SPIN(cond, bar) do { unsigned _sp = 0; while (cond) { __builtin_amdgcn_s_sleep(1); \
    if ((++_sp & 255u) == 0u) { if (xb_ld(&(bar)[XB_TMO])) break; if (_sp > XB_SPIN_CAP) { atomicAdd(&(bar)[XB_TMO], 1u); break; } } } } while (0)
struct XcdBarrier { unsigned* bar; unsigned x; volatile LAS unsigned* st; };
__device__ __forceinline__ XcdBarrier xcd_barrier_post(unsigned* bar, volatile LAS unsigned* st) {
    XcdBarrier b; b.bar = bar; b.x = xb_xcc_id(); b.st = st;
    if (threadIdx.x == 0) (void)xb_add(&bar[XB_XCNT(b.x)], 1u);
    return b;
}
__device__ __forceinline__ void xcd_barrier_complete(unsigned* bar, unsigned x, unsigned& nloc, unsigned& nx) {
    const unsigned G = gridDim.x * gridDim.y * gridDim.z;
    unsigned sum, cnt, mine, sp = 0u;
    for (;;) {
        sum = 0u; cnt = 0u; mine = 0u;
#pragma unroll
        for (unsigned j = 0; j < 16; ++j) { const unsigned c = xb_ld(&bar[XB_XCNT(j)]); sum += c; cnt += (c > 0u) ? 1u : 0u; mine = (j == x) ? c : mine; }
        if (sum == G) break;
        __builtin_amdgcn_s_sleep(1);
        if ((++sp & 255u) == 0u) { if (xb_ld(&bar[XB_TMO])) break; if (sp > XB_SPIN_CAP) { atomicAdd(&bar[XB_TMO], 1u); break; } }
    }
    nloc = mine > 0u ? mine : 1u; nx = cnt > 0u ? cnt : 1u;
}
__device__ __forceinline__ void xcd_barrier(const XcdBarrier& b) {
    asm volatile("s_waitcnt vmcnt(0)" ::: "memory");
    __syncthreads();
    if (threadIdx.x == 0) {
        unsigned* bar = b.bar;
        __builtin_amdgcn_s_waitcnt(0);
        unsigned nloc = b.st[0], nx = b.st[1];
        if (nloc == 0u) { xcd_barrier_complete(bar, b.x, nloc, nx); b.st[0] = nloc; b.st[1] = nx; }
        const unsigned old = xb_add(&bar[XB_XSUB(b.x)], 1u);
        const unsigned gen = old / nloc;
        if (old + 1u == (gen + 1u) * nloc) {
            __builtin_amdgcn_fence(__ATOMIC_RELEASE, "agent");
            asm volatile("s_waitcnt vmcnt(0)" ::: "memory");
            const unsigned og = xb_add(&bar[XB_TOP], 1u);
            const unsigned tg = og / nx;
            if (og + 1u == (tg + 1u) * nx) xb_add(&bar[XB_TOPGEN], 1u);
            else XB_SPIN(xb_ld(&bar[XB_TOPGEN]) == tg, bar);
            __builtin_amdgcn_fence(__ATOMIC_ACQUIRE, "agent");
            xb_add(&bar[XB_XGEN(b.x)], 1u);
            asm volatile("s_waitcnt vmcnt(0)" ::: "memory");
        } else {
            XB_SPIN(xb_ld(&bar[XB_XGEN(b.x)]) == gen, bar);
            __builtin_amdgcn_fence(__ATOMIC_ACQUIRE, "agent");
            asm volatile("s_waitcnt vmcnt(0)" ::: "memory");
        }
    }
    __syncthreads();
}
constexpr int CW_BAR = 4096;

struct Frame {
    LAS unsigned char* lds; unsigned char* ldsg;
    int tid, lane, wave, vcu, G, gw, NGW;
    unsigned char* ws; const float* const* in; float* out;
};
__device__ __forceinline__ int row_seqinfo(int row, int& pos, int& len) {
    const int b = row / SB, t = row - b * SB;
    if (t >= SEQ) { pos = t - SEQ; len = CTXL; return 2; }
    pos = t; len = SEQ; return b;
}

__device__ __forceinline__ void transpose_item(const float* W, int ldw, bf16* WT, int ldk, int row_off, LAS float* scr, int kb, int nb, int lane, int rstride = 1) {
    const int k0 = 64 * kb, n0 = 32 * nb;
    float tv[32];
#pragma unroll
    for (int i = 0; i < 32; ++i) tv[i] = __builtin_nontemporal_load(W + (size_t)(k0 + 2 * i + (lane >> 5)) * ldw + n0 + (lane & 31));
#pragma unroll
    for (int i = 0; i < 32; ++i) scr[(2 * i + (lane >> 5)) * 33 + (lane & 31)] = tv[i];
    asm volatile("s_waitcnt lgkmcnt(0)" ::: "memory");
    const int c = lane & 7;
#pragma unroll
    for (int j = 0; j < 4; ++j) { const int n = (lane >> 3) + 8 * j; const LAS float* s = scr + (8 * c) * 33 + n;
        v4u o; o.x = cvt_pk_bf16(s[0 * 33], s[1 * 33]); o.y = cvt_pk_bf16(s[2 * 33], s[3 * 33]); o.z = cvt_pk_bf16(s[4 * 33], s[5 * 33]); o.w = cvt_pk_bf16(s[6 * 33], s[7 * 33]);
        *(v4u*)(WT + (size_t)(row_off + n0 + rstride * n) * ldk + k0 + 8 * c) = o; }
    asm volatile("s_waitcnt lgkmcnt(0)" ::: "memory");
}
struct TJob { int in_idx; unsigned long long in_off; int K, N; unsigned long long dst_off; int row_off; };
#define NTJ 20
__constant__ TJob g_tj[NTJ] = {
    {8, 0ull * 2048 * 11264, 2048, 11264, WS_UPT + 0ull * 11264 * 2048 * 2, -1}, {8, 1ull * 2048 * 11264, 2048, 11264, WS_UPT + 1ull * 11264 * 2048 * 2, -1},
    {8, 2ull * 2048 * 11264, 2048, 11264, WS_UPT + 2ull * 11264 * 2048 * 2, -1}, {8, 3ull * 2048 * 11264, 2048, 11264, WS_UPT + 3ull * 11264 * 2048 * 2, -1},
    {11, 0ull * 5632 * 2048, 5632, 2048, WS_DNT + 0ull * 2048 * 5632 * 2, 0}, {11, 1ull * 5632 * 2048, 5632, 2048, WS_DNT + 1ull * 2048 * 5632 * 2, 0},
    {11, 2ull * 5632 * 2048, 5632, 2048, WS_DNT + 2ull * 2048 * 5632 * 2, 0}, {11, 3ull * 5632 * 2048, 5632, 2048, WS_DNT + 3ull * 2048 * 5632 * 2, 0},
    {13, 0ull * 2048 * 2048, 2048, 2048, WS_RWT, 0}, {13, 1ull * 2048 * 2048, 2048, 2048, WS_RWT, 2048}, {13, 2ull * 2048 * 2048, 2048, 2048, WS_RWT, 4096},
    {13, 3ull * 2048 * 2048, 2048, 2048, WS_RWT + 28ull * 256 * 2048 * 2, 0}, {13, 4ull * 2048 * 2048, 2048, 2048, WS_RWT + 28ull * 256 * 2048 * 2, 2048}, {13, 5ull * 2048 * 2048, 2048, 2048, WS_RWT + 28ull * 256 * 2048 * 2, 4096},
    {27, 0, 2048, 2048, WS_RWOT, 0}, {27, 1ull * 2048 * 2048, 2048, 2048, WS_RWOT + 2048ull * 2048 * 2, 0},
    {31, 0, 2048, 6144, WS_NAQKVT, 0}, {35, 0, 2048, 2048, WS_NAOT, 0}, {36, 0, 2048, 3072, WS_GAQKVT, -2}, {39, 0, 2048, 2048, WS_GAOT, 0},
};
__device__ __forceinline__ void pro_transposes(Frame& F) {
    LAS float* scr = (LAS float*)(F.lds + RING_OFF + F.wave * 16384);
    int base = 0;
    for (int jb = 0; jb < NTJ; ++jb) {
        const int K = g_tj[jb].K, N = g_tj[jb].N, nkb = K / 64, nnb = N / 32, nit = nkb * nnb;
        const float* W = F.in[g_tj[jb].in_idx] + g_tj[jb].in_off; bf16* WT = (bf16*)(F.ws + g_tj[jb].dst_off); const int ro = g_tj[jb].row_off;
        int first = (F.gw - base % F.NGW + F.NGW) % F.NGW;
        for (int it = first; it < nit; it += F.NGW) {
            const int nb = it % nnb; int roff = ro;
            if (ro < 0) { const int n0 = 32 * nb, nn = n0 < DFF ? n0 : n0 - DFF; roff = ((nn >> 7) * 256 + (n0 < DFF ? 0 : 128) + (nn & 127)) - n0; }
            int rstr = 1;
            if (ro == -2) { const int n0 = 32 * nb; roff = 0; if (n0 < 2560) { roff = ((n0 >> 6) * 64 + ((n0 >> 5) & 1)) - n0; rstr = 2; } }
            transpose_item(W, N, WT, K, roff, scr, it / nnb, nb, F.lane, rstr);
        }
        base += nit;
    }
}
__device__ __forceinline__ void pro_small(Frame& F) {
    const size_t gt = (size_t)F.vcu * 512 + F.tid, NT = (size_t)F.G * 512;
    for (int j = 0; j < 2; ++j) {
        bf16* RWT = (bf16*)(F.ws + WS_RWT) + (size_t)j * 28 * 256 * 2048;
        for (size_t i = gt; i < (size_t)1024 * 2048; i += NT) {
            const int rr = (int)(i / 2048), k = (int)(i % 2048), blk = rr >> 8, n = rr & 255; float v = 0.f;
            if (blk == 0) { const int d = n >> 7, q = n & 127; if (q < 96) v = F.in[15][(((size_t)j * 2 + d) * 2048 + k) * 96 + q]; }
            else if (blk == 1) { const int d = n >> 7, q = n & 127; if (q < 96) v = F.in[18][(((size_t)j * 2 + d) * 2048 + k) * 96 + q]; }
            else if (blk == 2) { v = F.in[20][((size_t)j * 2048 + k) * 256 + n]; }
            else { if (j == 1 && n < 64) v = F.in[29][(size_t)k * 64 + n]; }
            RWT[(size_t)(6144 + rr) * 2048 + k] = (bf16)(cvt_pk_bf16(v, 0.f) & 0xffffu);
        }
        bf16* L2T = (bf16*)(F.ws + WS_RL2T) + (size_t)j * 48 * 256 * 256;
        for (size_t i = gt; i < (size_t)12288 * 256; i += NT) {
            const int rr = (int)(i / 256), k = (int)(i % 256); float v = 0.f;
            if (rr < 4096) { const int d = rr / 2048, c = rr % 2048; const int kk = k - d * 128; if (kk >= 0 && kk < 96) v = F.in[16][(((size_t)j * 2 + d) * 96 + kk) * 2048 + c]; }
            else if (rr < 8192) { const int r2 = rr - 4096, d = r2 / 2048, c = r2 % 2048; const int kk = k - d * 128; if (kk >= 0 && kk < 96) v = F.in[19][(((size_t)j * 2 + d) * 96 + kk) * 2048 + c]; }
            else if (rr < 10240) { const int c = rr - 8192; v = F.in[21][((size_t)j * 256 + k) * 2048 + c]; }
            else { const int c = rr - 10240; if (j == 1 && k < 64) v = F.in[30][(size_t)k * 2048 + c]; }
            L2T[i] = (bf16)(cvt_pk_bf16(v, 0.f) & 0xffffu);
        }
    }
}
__device__ __forceinline__ void pro_mod(Frame& F) {
    LAS float* sl = (LAS float*)(F.lds + RING_OFF);
    LAS float* red = (LAS float*)(F.lds + RING_OFF + 32768);
    for (int i = F.tid; i < 3 * 2048; i += 512) { const int s = i / 2048, d = i % 2048; const float c = (s < 2) ? F.in[1][s * 2048 + d] : F.in[3][d]; sl[i] = c * sigmoidf_(c); }
    __syncthreads();
    float* MOD = (float*)(F.ws + WS_MOD);
    for (int it = F.vcu; it < 256; it += F.G) {
        const int l = it >> 6, blk = it & 63, col = 192 * blk + 3 * F.lane;
        const float* W = F.in[4] + (size_t)l * 2048 * 12288 + col;
        float a[3][3];
#pragma unroll
        for (int s = 0; s < 3; ++s) { a[s][0] = 0.f; a[s][1] = 0.f; a[s][2] = 0.f; }
        const int d0 = F.wave * 256;
#pragma unroll 8
        for (int dd = 0; dd < 256; ++dd) {
            const int d = d0 + dd; const float* wp = W + (size_t)d * 12288;
            const float w0 = __builtin_nontemporal_load(wp), w1 = __builtin_nontemporal_load(wp + 1), w2 = __builtin_nontemporal_load(wp + 2);
#pragma unroll
            for (int s = 0; s < 3; ++s) { const float sv = sl[s * 2048 + d]; a[s][0] += sv * w0; a[s][1] += sv * w1; a[s][2] += sv * w2; }
        }
#pragma unroll
        for (int s = 0; s < 3; ++s)
#pragma unroll
            for (int e = 0; e < 3; ++e) red[(F.wave * 9 + s * 3 + e) * 64 + F.lane] = a[s][e];
        __syncthreads();
        for (int idx = F.tid; idx < 576; idx += 512) {
            const int s = idx / 192, cc = idx % 192, ln = cc / 3, e = cc % 3; float v = 0.f;
#pragma unroll
            for (int w = 0; w < 8; ++w) v += red[(w * 9 + s * 3 + e) * 64 + ln];
            const int j = 192 * blk + cc;
            MOD[((size_t)l * 3 + s) * 12288 + j] = v + F.in[5][(size_t)l * 12288 + j];
        }
        __syncthreads();
    }
}

__device__ __forceinline__ void phase_norm(Frame& F, const float* gain, const float* mod3  , bf16* Hout, float* H32, int nparts, const float* pgate  , int lat_only,
                                           const float* xin_lat = nullptr, const float* xin_ctx = nullptr  ) {
    bf16* X = (bf16*)(F.ws + WS_X); const float* PART = (const float*)(F.ws + WS_PART);
    for (int li = F.gw; li < NB * SEQ; li += F.NGW) {
        const int s = li / SEQ, pos = li - s * SEQ, row = s * SB + pos;
        v2u* xr = (v2u*)(X + (size_t)row * D) + F.lane;
        f32x4 v[8]; float ss = 0.f;
        if (xin_lat) { const f32x4* xs = (const f32x4*)(xin_lat + ((size_t)s * SEQ + pos) * D) + F.lane;
#pragma unroll
            for (int j = 0; j < 8; ++j) v[j] = xs[64 * j];
        } else {
#pragma unroll
            for (int j = 0; j < 8; ++j) { const v2u t_ = xr[64 * j]; v[j] = (f32x4){bflo(t_.x), bfhi(t_.x), bflo(t_.y), bfhi(t_.y)}; }
        }
#pragma unroll
        for (int j = 0; j < 8; ++j) ss += (v[j].x * v[j].x + v[j].y * v[j].y) + (v[j].z * v[j].z + v[j].w * v[j].w);
        const float rstd = rsqrtf(wave_sum(ss) * (1.f / D) + NORM_EPS);
        const float* sh = mod3 + (size_t)s * (6 * D); const float* sc = sh + D;
#pragma unroll
        for (int j = 0; j < 8; ++j) {
            const int col = 4 * F.lane + 256 * j;
            const f32x4 g = *(const f32x4*)(gain + col), a = *(const f32x4*)(sc + col), b = *(const f32x4*)(sh + col);
            f32x4 y = v[j] * rstd * g; y = y * (a + 1.0f) + b;
            v2u o; o.x = cvt_pk_bf16(y.x, y.y); o.y = cvt_pk_bf16(y.z, y.w);
            *(v2u*)(Hout + (size_t)row * D + col) = o;
            if (H32) *(f32x4*)(H32 + (size_t)row * D + col) = y;
        }
    }
    if (lat_only) return;
    LAS float* red = (LAS float*)(F.lds + RING_OFF);
    int par = 0;
    for (int ci = F.vcu; ci < NB * CTXL; ci += F.G, par ^= 1) {
        const int bb = ci / CTXL, pos = ci - bb * CTXL, row = bb * SB + SEQ + pos, col = 256 * F.wave + 4 * F.lane;
        v2u* xr = (v2u*)(X + (size_t)row * D + col);
        f32x4 v;
        if (xin_ctx) v = *(const f32x4*)(xin_ctx + ((size_t)bb * CTXL + pos) * D + col);
        else { const v2u t_ = *xr; v = (f32x4){bflo(t_.x), bfhi(t_.x), bflo(t_.y), bfhi(t_.y)}; }
        if (nparts > 0) {
            f32x4 pv[11];
#pragma unroll
            for (int k = 0; k < 11; ++k) pv[k] = (k < nparts) ? *(const f32x4*)(PART + ((size_t)k * 512 + ci) * D + col) : (f32x4){0.f, 0.f, 0.f, 0.f};
            f32x4 a = pv[0];
#pragma unroll
            for (int k = 1; k < 11; ++k) a += pv[k];
            v += a * *(const f32x4*)(pgate + col);
        }
        if (nparts > 0 || xin_ctx) { v2u t_; t_.x = cvt_pk_bf16(v.x, v.y); t_.y = cvt_pk_bf16(v.z, v.w); *xr = t_; }
        const float ssw = wave_sum((v.x * v.x + v.y * v.y) + (v.z * v.z + v.w * v.w));
        if (F.lane == 0) red[par * 8 + F.wave] = ssw;
        __syncthreads();
        float ss = 0.f;
#pragma unroll
        for (int w = 0; w < 8; ++w) ss += red[par * 8 + w];
        const float rstd = rsqrtf(ss * (1.f / D) + NORM_EPS);
        const float* sh = mod3 + (size_t)2 * (6 * D); const float* sc = sh + D;
        const f32x4 g = *(const f32x4*)(gain + col), a_ = *(const f32x4*)(sc + col), b_ = *(const f32x4*)(sh + col);
        f32x4 y = v * rstd * g; y = y * (a_ + 1.0f) + b_;
        v2u o; o.x = cvt_pk_bf16(y.x, y.y); o.y = cvt_pk_bf16(y.z, y.w);
        *(v2u*)(Hout + (size_t)row * D + col) = o;
        if (H32) *(f32x4*)(H32 + (size_t)row * D + col) = y;
    }
    __syncthreads();
}
__device__ __forceinline__ void phase_xm(Frame& F, const float* mu  ) {
    const bf16* Hb = (const bf16*)(F.ws + WS_H); bf16* XM = (bf16*)(F.ws + WS_XM);
    for (int it = F.gw; it < 4 * M; it += F.NGW) {
        const int row = it >> 2, jq = it & 3;
        int pos, len; (void)row_seqinfo(row, pos, len);
        const bool hp = pos > 0, hn = pos + 1 < len;
#pragma unroll
        for (int j2 = 0; j2 < 2; ++j2) {
            const int j = 2 * jq + j2;
            const int col = 4 * F.lane + 256 * j;
            const v2u z2 = {0u, 0u};
            const v2u hr = *(const v2u*)(Hb + (size_t)row * D + col);
            const v2u ar = hp ? *(const v2u*)(Hb + (size_t)(row - 1) * D + col) : z2, br = hn ? *(const v2u*)(Hb + (size_t)(row + 1) * D + col) : z2;
            const f32x4 h = {bflo(hr.x), bfhi(hr.x), bflo(hr.y), bfhi(hr.y)}, a = {bflo(ar.x), bfhi(ar.x), bflo(ar.y), bfhi(ar.y)}, b = {bflo(br.x), bfhi(br.x), bflo(br.y), bfhi(br.y)};
            const f32x4 xx = (a + b) * 0.5f - h;
#pragma unroll
            for (int p = 0; p < 6; ++p) {
                const f32x4 m = *(const f32x4*)(mu + p * D + col); const f32x4 y = h + xx * m;
                v2u o; o.x = cvt_pk_bf16(y.x, y.y); o.y = cvt_pk_bf16(y.z, y.w);
                *(v2u*)(XM + ((size_t)p * M + row) * D + col) = o;
            }
        }
    }
}
constexpr int SCH = 16, NCHUNK = SB / SCH;
__device__ __forceinline__ int rho0(int hi, int i) { return (i & 3) + 4 * hi + 8 * (i >> 2); }
__device__ __forceinline__ int chunk_row0(int b, int d, int c) { const int sg = 16 * c; if (sg < CTXL) return b * SB + SEQ + (d ? CTXL - 1 - sg : sg); const int t = sg - CTXL; return b * SB + (d ? SEQ - 1 - t : t); }
__device__ __forceinline__ float sum64(float v) {
    v = sum16(v);
    { const auto x = __builtin_amdgcn_permlane16_swap(__float_as_uint(v), __float_as_uint(v), false, false); v = __uint_as_float(x[0]) + __uint_as_float(x[1]); }
    { const auto x = __builtin_amdgcn_permlane32_swap(__float_as_uint(v), __float_as_uint(v), false, false); v = __uint_as_float(x[0]) + __uint_as_float(x[1]); }
    return v;
}
__device__ __forceinline__ bf16x8 pack8(float a0, float a1, float a2, float a3, float a4, float a5, float a6, float a7) {
    v4u w; w.x = cvt_pk_bf16_v(a0, a1); w.y = cvt_pk_bf16_v(a2, a3); w.z = cvt_pk_bf16_v(a4, a5); w.w = cvt_pk_bf16_v(a6, a7); return __builtin_bit_cast(bf16x8, w);
}
typedef float f32x16 __attribute__((ext_vector_type(16)));
__device__ __forceinline__ bf16x8 mk8(unsigned a, unsigned b, unsigned c, unsigned d) { return __builtin_bit_cast(bf16x8, (v4u){a, b, c, d}); }
__device__ __forceinline__ constexpr int brev4(int s) { return ((s & 1) << 3) | ((s & 2) << 1) | ((s & 4) >> 1) | ((s & 8) >> 3); }
__device__ __forceinline__ float red16x64(const float (&x)[16], int lane) {
    const bool b3 = lane & 8, b2 = lane & 4, b1 = lane & 2, b0 = lane & 1;
    float y[8], z[4], w[2];
#pragma unroll
    for (int i = 0; i < 8; ++i) { const float keep = b3 ? x[2 * i + 1] : x[2 * i], send = b3 ? x[2 * i] : x[2 * i + 1]; y[i] = keep + dppmov<0x140>(send); }
#pragma unroll
    for (int i = 0; i < 4; ++i) { const float keep = b2 ? y[2 * i + 1] : y[2 * i], send = b2 ? y[2 * i] : y[2 * i + 1]; z[i] = keep + dppmov<0x141>(send); }
#pragma unroll
    for (int i = 0; i < 2; ++i) { const float keep = b1 ? z[2 * i + 1] : z[2 * i], send = b1 ? z[2 * i] : z[2 * i + 1]; w[i] = keep + dppmov<0x4E>(send); }
    float v; { const float keep = b0 ? w[1] : w[0], send = b0 ? w[0] : w[1]; v = keep + dppmov<0xB1>(send); }
    { const auto t = __builtin_amdgcn_permlane16_swap(__float_as_uint(v), __float_as_uint(v), false, false); v = __uint_as_float(t[0]) + __uint_as_float(t[1]); }
    { const auto t = __builtin_amdgcn_permlane32_swap(__float_as_uint(v), __float_as_uint(v), false, false); v = __uint_as_float(t[0]) + __uint_as_float(t[1]); }
    return v;
}
constexpr size_t WS_RS = WS_OPS;
constexpr size_t WS_VF = WS_OPS + 2 * MiB;
__device__ __forceinline__ void phase_rs(Frame& F, int j) {
    const bf16* Kt = (const bf16*)(F.ws + WS_RKV + SZ_ACT); const float* k_k = F.in[22] + (size_t)j * D; float* RS = (float*)(F.ws + WS_RS);
    const int lane = F.lane;
    f32x4 kg[8];
#pragma unroll
    for (int i = 0; i < 8; ++i) kg[i] = *(const f32x4*)(k_k + 32 * lane + 4 * i);
    for (int row = F.gw; row < M; row += F.NGW) {
        const v4u* kr = (const v4u*)(Kt + (size_t)row * D + 32 * lane);
        float acc = 0.f;
#pragma unroll
        for (int i = 0; i < 4; ++i) { const v4u t = kr[i];
            const float x0 = bflo(t.x) * kg[2 * i][0], x1 = bfhi(t.x) * kg[2 * i][1], x2 = bflo(t.y) * kg[2 * i][2], x3 = bfhi(t.y) * kg[2 * i][3];
            const float x4 = bflo(t.z) * kg[2 * i + 1][0], x5 = bfhi(t.z) * kg[2 * i + 1][1], x6 = bflo(t.w) * kg[2 * i + 1][2], x7 = bfhi(t.w) * kg[2 * i + 1][3];
            acc += x0 * x0 + x1 * x1 + x2 * x2 + x3 * x3 + x4 * x4 + x5 * x5 + x6 * x6 + x7 * x7; }
        acc += dppmov<0xB1>(acc);
        if (!(lane & 1)) RS[(size_t)row * 32 + (lane >> 1)] = __builtin_amdgcn_rsqf(fmaxf(acc, 1e-24f));
    }
}
constexpr int FS_NS = 8, FS_SLOT = 11776, FS_A4 = 4352, FS_AW = 8448, FS_A23 = 9472, FS_GAM = 10496, FS_V = 10752;
constexpr int FS_SCR = FS_NS * FS_SLOT, FS_SCRSZ = 5440, FS_FLAGS = FS_SCR + 6 * FS_SCRSZ;
static_assert(FS_FLAGS + 64 <= RING_BYTES, "fused scan LDS");
__device__ __forceinline__ bf16x8 fs_frag(const LAS unsigned char* base, int mb, int jj, int m, int g) {
    const v2u lo = *(const LAS v2u*)(base + mb * 2176 + (8 * jj + g) * 136 + m * 8), hh = *(const LAS v2u*)(base + mb * 2176 + (8 * jj + 4 + g) * 136 + m * 8);
    return __builtin_bit_cast(bf16x8, (v4u){lo.x, lo.y, hh.x, hh.y});
}
__device__ __forceinline__ void phase_scanfused(Frame& F, int j, const bf16* Vsrc) {
    const bf16* R = (const bf16*)(F.ws + WS_RKV); const bf16* Kt = (const bf16*)(F.ws + WS_RKV + SZ_ACT);
    const unsigned short* DEC = (const unsigned short*)(F.ws + WS_DEC); const bf16* AA = (const bf16*)(F.ws + WS_AA);
    const float* k_k = F.in[22] + (size_t)j * D; const float* k_a = F.in[23] + (size_t)j * D; const float* r_k = F.in[24] + (size_t)j * D;
    float* BON = (float*)(F.ws + WS_BON); bf16* Y = (bf16*)(F.ws + WS_Y);
    const int lane = F.lane, wave = F.wave, n16 = lane & 15, g = lane >> 4;
    LAS unsigned char* slots = F.lds + RING_OFF;
    volatile LAS unsigned* flg = (volatile LAS unsigned*)(F.lds + RING_OFF + FS_FLAGS);
    for (int u = F.vcu; u < 256; u += F.G) {
        const int chain = u >> 1, vh = u & 1, d = chain & 1, h = (chain >> 1) & 31, b = chain >> 6;
        const int dstep = d ? -1 : 1; const size_t dofs = (size_t)d * M * D;
        if (F.tid < 16) flg[F.tid] = 0u;
        __syncthreads();
        if (wave >= 2) {
            LAS unsigned char* scr = slots + FS_SCR + (wave - 2) * FS_SCRSZ;
            LAS float* GL = (LAS float*)scr;
            LAS float* TL = (LAS float*)(scr + 4352);
            const int ch = h * 64 + lane;
            const float kkg = k_k[ch], kag = k_a[ch], rkg = r_k[ch];
            const int wofs = (lane >> 2) * 136 + (lane & 3) * 2;
            const int vofs = h * 128 + lane * 2;
            const __amdgpu_buffer_rsrc_t rR = __builtin_amdgcn_make_buffer_rsrc((void*)R, 0, 0x7fffffff, 0x00020000), rK = __builtin_amdgcn_make_buffer_rsrc((void*)Kt, 0, 0x7fffffff, 0x00020000);
            const __amdgpu_buffer_rsrc_t rA = __builtin_amdgcn_make_buffer_rsrc((void*)(AA + dofs), 0, 0x7fffffff, 0x00020000), rW = __builtin_amdgcn_make_buffer_rsrc((void*)(DEC + dofs), 0, 0x7fffffff, 0x00020000);
            const float* RS = (const float*)(F.ws + WS_RS);
            while (true) {
                int c; { unsigned old_; const unsigned one_ = (lane == 0) ? 1u : 0u, addr_ = (unsigned)(size_t)(F.lds + RING_OFF + FS_FLAGS + 40);
                    asm volatile("ds_add_rtn_u32 %0, %1, %2\n\ts_waitcnt lgkmcnt(0)" : "=v"(old_) : "v"(addr_), "v"(one_) : "memory"); c = __builtin_amdgcn_readfirstlane((int)old_); }
                if (c >= NCHUNK) break;
                const int row0 = chunk_row0(b, d, c);
                unsigned short rb[16], kb_[16], ab[16], wf[16];
#pragma unroll
                for (int s = 0; s < 16; ++s) { const int so = (row0 + dstep * s) * (D * 2);
                    rb[s] = __builtin_amdgcn_raw_buffer_load_b16(rR, vofs, so, 0); kb_[s] = __builtin_amdgcn_raw_buffer_load_b16(rK, vofs, so, 0);
                    ab[s] = __builtin_amdgcn_raw_buffer_load_b16(rA, vofs, so, 0); wf[s] = __builtin_amdgcn_raw_buffer_load_b16(rW, vofs, so, 0); }
                const float rsv = RS[(size_t)(row0 + dstep * (lane & 15)) * 32 + h];
                const size_t vo_ = (size_t)(row0 + dstep * (lane >> 2)) * D + h * 64 + vh * 32 + (lane & 3) * 8;
                v4u vreg = *(const v4u*)(Vsrc + vo_);
                if (j > 0) {
                    const v4u v0r = *(const v4u*)((const bf16*)(F.ws + WS_V0) + vo_), vgr = *(const v4u*)((const bf16*)(F.ws + WS_VG) + vo_);
                    v4u o;
                    o.x = cvt_pk_bf16(bflo(vreg.x) + (bflo(v0r.x) - bflo(vreg.x)) * bflo(vgr.x), bfhi(vreg.x) + (bfhi(v0r.x) - bfhi(vreg.x)) * bfhi(vgr.x));
                    o.y = cvt_pk_bf16(bflo(vreg.y) + (bflo(v0r.y) - bflo(vreg.y)) * bflo(vgr.y), bfhi(vreg.y) + (bfhi(v0r.y) - bfhi(vreg.y)) * bfhi(vgr.y));
                    o.z = cvt_pk_bf16(bflo(vreg.z) + (bflo(v0r.z) - bflo(vreg.z)) * bflo(vgr.z), bfhi(vreg.z) + (bfhi(v0r.z) - bfhi(vreg.z)) * bfhi(vgr.z));
                    o.w = cvt_pk_bf16(bflo(vreg.w) + (bflo(v0r.w) - bflo(vreg.w)) * bflo(vgr.w), bfhi(vreg.w) + (bfhi(v0r.w) - bfhi(vreg.w)) * bfhi(vgr.w));
                    vreg = o;
                    if (d == 0) *(v4u*)((bf16*)(F.ws + WS_VF) + vo_) = o;
                }
                if (c >= FS_NS) { const unsigned need = (unsigned)(c - FS_NS + 1); unsigned sp = 0;
                    while (true) { const unsigned d0 = flg[8], d1 = flg[9]; if ((d0 < d1 ? d0 : d1) >= need || ++sp > (1u << 20)) break; __builtin_amdgcn_s_sleep(2); } }
                asm volatile("" ::: "memory");
                LAS unsigned char* sl = slots + (c % FS_NS) * FS_SLOT;
                float rf[16], kf[16], af[16];
#pragma unroll
                for (int s = 0; s < 16; ++s) { rf[s] = bflo(rb[s]); kf[s] = bflo(kb_[s]); af[s] = bflo(ab[s]); }
                if ((c & 1) == vh) {
                    float xs[16];
#pragma unroll
                    for (int s = 0; s < 16; ++s) { const float kd = kf[s] * (1.f + (af[s] - 1.f) * kag); xs[s] = rf[s] * kd * rkg; }
                    const float bnv = red16x64(xs, lane);
                    if (lane < 16) BON[((size_t)d * M + (row0 + dstep * brev4(lane))) * 32 + h] = bnv;
                }
                float G = 1.f; unsigned qprev = 0u, zprev = 0u;
#pragma unroll
                for (int s2 = 0; s2 < 8; ++s2) {
                    float pv[2], rv[2], qv[2], zv[2];
#pragma unroll
                    for (int e = 0; e < 2; ++e) { const int s = 2 * s2 + e;
                        const float r = rf[s], kx = kf[s], a = af[s]; const _Float16 wh = __builtin_bit_cast(_Float16, wf[s]);
                        const float kk = kx * kkg * __uint_as_float((unsigned)__builtin_amdgcn_readlane((int)__float_as_uint(rsv), s));
                        const float bb = kk * a, kd = kx * (1.f + (a - 1.f) * kag);
                        const float gp = G; G = __builtin_fmaf(-G, (float)wh, G); const float inv = __builtin_amdgcn_rcpf(G);
                        pv[e] = gp * kk; rv[e] = G * r; qv[e] = bb * inv; zv[e] = kd * inv; }
                    const unsigned pp = cvt_pk_bf16(pv[0], pv[1]), rr = cvt_pk_bf16(rv[0], rv[1]), qq = cvt_pk_bf16(qv[0], qv[1]), zz = cvt_pk_bf16(zv[0], zv[1]);
                    const int s = 2 * s2;
                    *(LAS unsigned short*)(sl + wofs + s * 8) = (unsigned short)(pp & 0xffffu); *(LAS unsigned short*)(sl + wofs + s * 8 + 8) = (unsigned short)(pp >> 16);
                    *(LAS unsigned short*)(sl + 2176 + wofs + s * 8) = (unsigned short)(rr & 0xffffu); *(LAS unsigned short*)(sl + 2176 + wofs + s * 8 + 8) = (unsigned short)(rr >> 16);
                    *(LAS unsigned short*)(scr + wofs + s * 8) = (unsigned short)(qq & 0xffffu); *(LAS unsigned short*)(scr + wofs + s * 8 + 8) = (unsigned short)(qq >> 16);
                    *(LAS unsigned short*)(scr + 2176 + wofs + s * 8) = (unsigned short)(zz & 0xffffu); *(LAS unsigned short*)(scr + 2176 + wofs + s * 8 + 8) = (unsigned short)(zz >> 16);
                    if (s2 & 1) { *(LAS v2u*)(sl + FS_A4 + lane * 8 + (s2 >> 1) * 1024) = (v2u){qprev ^ 0x80008000u, qq ^ 0x80008000u}; *(LAS v2u*)(sl + FS_A4 + lane * 8 + (s2 >> 1) * 1024 + 512) = (v2u){zprev, zz}; }
                    else { qprev = qq; zprev = zz; }
                }
                *(LAS float*)(sl + FS_GAM + lane * 4) = G;
                *(LAS v4u*)(sl + FS_V + lane * 16) = vreg;
                asm volatile("s_waitcnt lgkmcnt(0)" ::: "memory");
                f32x4 gt[4];
#pragma unroll
                for (int t = 0; t < 4; ++t) {
                    f32x4 acc = {0.f, 0.f, 0.f, 0.f};
#pragma unroll
                    for (int jj = 0; jj < 2; ++jj) acc = __builtin_amdgcn_mfma_f32_16x16x32_bf16(fs_frag(scr, t >> 1, jj, n16, g), fs_frag(sl, t & 1, jj, n16, g), acc, 0, 0, 0);
                    gt[t] = acc;
                }
                asm volatile("s_waitcnt lgkmcnt(0)" ::: "memory");
#pragma unroll
                for (int r = 0; r < 4; ++r) GL[(4 * g + r) * 33 + n16] = gt[0][r];
                asm volatile("s_waitcnt lgkmcnt(0)" ::: "memory");
                if (lane < 16) {
                    f32x2 Np[56]; float Ns[8];
                    { int pi = 0;
#pragma unroll
                      for (int s = 0; s < 15; ++s) {
                          if (!(s & 1)) Ns[s >> 1] = GL[s * 33 + s + 1];
#pragma unroll
                          for (int m = (s >> 1) + 1; m < 8; ++m) { Np[pi] = (f32x2){GL[s * 33 + 2 * m], GL[s * 33 + 2 * m + 1]}; ++pi; }
                      } }
                    f32x2 ac[8];
#pragma unroll
                    for (int m = 0; m < 8; ++m) ac[m] = (f32x2){(lane == 2 * m) ? 1.f : 0.f, (lane == 2 * m + 1) ? 1.f : 0.f};
                    { int pi = 0;
#pragma unroll
                      for (int s = 0; s < 15; ++s) {
                          const float Ts = (s & 1) ? ac[s >> 1].y : ac[s >> 1].x;
                          if (!(s & 1)) ac[s >> 1].y -= Ts * Ns[s >> 1];
                          const f32x2 tv = {Ts, Ts};
#pragma unroll
                          for (int m = (s >> 1) + 1; m < 8; ++m) { ac[m] -= tv * Np[pi]; ++pi; }
                      } }
#pragma unroll
                    for (int t = 0; t < 16; ++t) TL[lane * 17 + t] = (t & 1) ? ac[t >> 1].y : ac[t >> 1].x;
                }
                asm volatile("s_waitcnt lgkmcnt(0)" ::: "memory");
                {   const int m = n16;
                    float aw[8], a23[8];
#pragma unroll
                    for (int i = 0; i < 4; ++i) {
                        const int s = 4 * g + i;
                        const float gzp = gt[2][i], gzr = gt[3][i], gqr = gt[1][i], tv_ = TL[s * 17 + m];
                        aw[i] = (s < m) ? gzp : 0.f;
                        aw[4 + i] = (s <= m) ? gzr : 0.f;
                        a23[i] = tv_;
                        a23[4 + i] = (s <= m) ? -gqr : 0.f;
                    }
                    *(LAS bf16x8*)(sl + FS_AW + lane * 16) = pack8(aw[0], aw[1], aw[2], aw[3], aw[4], aw[5], aw[6], aw[7]);
                    *(LAS bf16x8*)(sl + FS_A23 + lane * 16) = pack8(a23[0], a23[1], a23[2], a23[3], a23[4], a23[5], a23[6], a23[7]);
                }
                asm volatile("s_waitcnt lgkmcnt(0)" ::: "memory");
                if (lane == 0) flg[c % FS_NS] = (unsigned)(c + 1);
            }
        } else {
            f32x4 S0 = {0.f, 0.f, 0.f, 0.f}, S1 = S0, S2 = S0, S3 = S0;
            const f32x4 z4 = {0.f, 0.f, 0.f, 0.f};
            __builtin_amdgcn_s_setprio(2);
            for (int c = 0; c < NCHUNK; ++c) {
                { unsigned sp = 0; while (flg[c % FS_NS] != (unsigned)(c + 1) && ++sp < (1u << 20)) __builtin_amdgcn_s_sleep(1); }
                asm volatile("" ::: "memory");
                const LAS unsigned char* sl = slots + (c % FS_NS) * FS_SLOT;
                bf16x8 a1[4], a4[4];
#pragma unroll
                for (int q = 0; q < 4; ++q) {
                    a1[q] = fs_frag(sl, q >> 1, q & 1, n16, g);
                    const v2u lo = *(const LAS v2u*)(sl + FS_A4 + g * 1024 + (16 * q + n16) * 8), hh = *(const LAS v2u*)(sl + FS_A4 + g * 1024 + 512 + (16 * q + n16) * 8);
                    a4[q] = __builtin_bit_cast(bf16x8, (v4u){lo.x, lo.y, hh.x, hh.y});
                }
                const bf16x8 awm = *(const LAS bf16x8*)(sl + FS_AW + lane * 16), a23 = *(const LAS bf16x8*)(sl + FS_A23 + lane * 16);
                f32x4 gam[4];
#pragma unroll
                for (int kb = 0; kb < 4; ++kb) gam[kb] = *(const LAS f32x4*)(sl + FS_GAM + (kb * 16 + 4 * g) * 4);
                unsigned vv[4];
#pragma unroll
                for (int i = 0; i < 4; ++i) vv[i] = *(const LAS unsigned short*)(sl + FS_V + (4 * g + i) * 64 + (16 * wave + n16) * 2);
                asm volatile("s_waitcnt lgkmcnt(0)" ::: "memory");
                if (lane == 0) flg[8 + wave] = (unsigned)(c + 1);
                const unsigned v01 = vv[0] | (vv[1] << 16), v23 = vv[2] | (vv[3] << 16);
                const bf16x8 VL = mk8(v01, v23, 0u, 0u), VU = mk8(0u, 0u, v01, v23);
                const bf16x8 sb0 = mk8(cvt_pk_bf16_v(S0[0], S0[1]), cvt_pk_bf16_v(S0[2], S0[3]), cvt_pk_bf16_v(S1[0], S1[1]), cvt_pk_bf16_v(S1[2], S1[3]));
                const bf16x8 sb1 = mk8(cvt_pk_bf16_v(S2[0], S2[1]), cvt_pk_bf16_v(S2[2], S2[3]), cvt_pk_bf16_v(S3[0], S3[1]), cvt_pk_bf16_v(S3[2], S3[3]));
                f32x4 accP = __builtin_amdgcn_mfma_f32_16x16x32_bf16(awm, VL, z4, 0, 0, 0);
                f32x4 accR = __builtin_amdgcn_mfma_f32_16x16x32_bf16(awm, VU, z4, 0, 0, 0);
                accP = __builtin_amdgcn_mfma_f32_16x16x32_bf16(a1[0], sb0, accP, 0, 0, 0);
                accR = __builtin_amdgcn_mfma_f32_16x16x32_bf16(a1[2], sb0, accR, 0, 0, 0);
                accP = __builtin_amdgcn_mfma_f32_16x16x32_bf16(a1[1], sb1, accP, 0, 0, 0);
                accR = __builtin_amdgcn_mfma_f32_16x16x32_bf16(a1[3], sb1, accR, 0, 0, 0);
                const bf16x8 RL = mk8(cvt_pk_bf16_v(accP[0], accP[1]), cvt_pk_bf16_v(accP[2], accP[3]), 0u, 0u);
                const f32x4 acc2 = __builtin_amdgcn_mfma_f32_16x16x32_bf16(a23, RL, z4, 0, 0, 0);
                const unsigned u01 = cvt_pk_bf16_v(acc2[0], acc2[1]), u23 = cvt_pk_bf16_v(acc2[2], acc2[3]);
                const bf16x8 UV = mk8(u01, u23, v01, v23), UU = mk8(0u, 0u, u01, u23);
                S0 = __builtin_amdgcn_mfma_f32_16x16x32_bf16(a4[0], UV, S0, 0, 0, 0);
                S1 = __builtin_amdgcn_mfma_f32_16x16x32_bf16(a4[1], UV, S1, 0, 0, 0);
                S2 = __builtin_amdgcn_mfma_f32_16x16x32_bf16(a4[2], UV, S2, 0, 0, 0);
                S3 = __builtin_amdgcn_mfma_f32_16x16x32_bf16(a4[3], UV, S3, 0, 0, 0);
                accR = __builtin_amdgcn_mfma_f32_16x16x32_bf16(a23, UU, accR, 0, 0, 0);
                const int row0 = chunk_row0(b, d, c);
#pragma unroll
                for (int r = 0; r < 4; ++r) Y[dofs + (size_t)(row0 + dstep * (4 * g + r)) * D + h * 64 + vh * 32 + 16 * wave + n16] = (bf16)(cvt_pk_bf16_v(accR[r], 0.f) & 0xffffu);
                S0 *= gam[0]; S1 *= gam[1]; S2 *= gam[2]; S3 *= gam[3];
            }
            __builtin_amdgcn_s_setprio(0);
        }
        __syncthreads();
    }
}
__device__ __forceinline__ void phase_readout(Frame& F, int j, const bf16* Vsrc, int lat_only) {
    const bf16* GG = (const bf16*)(F.ws + WS_GG); const bf16* Y = (const bf16*)(F.ws + WS_Y); const float* BON = (const float*)(F.ws + WS_BON);
    bf16* O = (bf16*)(F.ws + WS_O);
    const float* ln_g = F.in[25] + (size_t)j * D; const float* ln_b = F.in[26] + (size_t)j * D;
    const int nrows = lat_only ? NB * SEQ : M;
    for (int it = F.gw; it < 4 * nrows; it += F.NGW) {
        const int ri = it >> 2, jq = it & 3;
        const int row = lat_only ? (ri / SEQ) * SB + (ri % SEQ) : ri;
#pragma unroll
        for (int j2 = 0; j2 < 2; ++j2) {
            const int jj = 2 * jq + j2;
            const int col = 4 * F.lane + 256 * jj; const size_t o = (size_t)row * D + col; const int head = col >> 6;
            const v2u y0r = *(const v2u*)(Y + o), y1r = *(const v2u*)(Y + (size_t)M * D + o);
            const f32x4 y = (f32x4){bflo(y0r.x) + bflo(y1r.x), bfhi(y0r.x) + bfhi(y1r.x), bflo(y0r.y) + bflo(y1r.y), bfhi(y0r.y) + bfhi(y1r.y)};
            const float bon = BON[(size_t)row * 32 + head] + BON[((size_t)M + row) * 32 + head];
            const float mean = sum16((y.x + y.y) + (y.z + y.w)) * (1.f / 64.f);
            const f32x4 dy = y - mean;
            const float var = sum16((dy.x * dy.x + dy.y * dy.y) + (dy.z * dy.z + dy.w * dy.w)) * (1.f / 64.f);
            const float rs = rsqrtf(var + GN_EPS);
            const v2u vr = *(const v2u*)(Vsrc + o), gr = *(const v2u*)(GG + o);
            const f32x4 v = {bflo(vr.x), bfhi(vr.x), bflo(vr.y), bfhi(vr.y)}, g = {bflo(gr.x), bfhi(gr.x), bflo(gr.y), bfhi(gr.y)};
            const f32x4 lg = *(const f32x4*)(ln_g + col), lb = *(const f32x4*)(ln_b + col);
            const f32x4 ov = (dy * rs * lg + lb + v * bon) * g;
            v2u w; w.x = cvt_pk_bf16(ov.x, ov.y); w.y = cvt_pk_bf16(ov.z, ov.w);
            *(v2u*)(O + o) = w;
        }
    }
}
__device__ __forceinline__ void phase_attn_gqa(Frame& F) {
    const bf16* QKV = (const bf16*)(F.ws + WS_QKV); bf16* O = (bf16*)(F.ws + WS_O);
    att::NaInfo na{0, 0, nullptr};
    for (int u = F.vcu; u < 512 + 32; u += F.G) {
        int b, h, qrow, NT, first0;
        if (u < 512) { const int kvg = u >> 6; b = kvg >> 2; h = (kvg & 3) * 4 + ((u >> 4) & 3); qrow = (u & 15) * 256; NT = SB / 64; first0 = 0; }
        else { const int v = u - 512; b = v >> 4; h = v & 15; qrow = SEQ; NT = CTXL / 64; first0 = SEQ; }
        const int kvh = h >> 2;
        const bf16* Qb = QKV + ((size_t)b * SB + qrow) * 3072 + h * HD;
        const bf16* Kh = QKV + (size_t)b * SB * 3072 + 2048 + kvh * HD; const bf16* Vh = Kh + 512;
        att::attn_unit<3072, 3072, 2048, false>(Qb, Kh, Vh, O + ((size_t)b * SB + qrow) * D + h * HD, NT, NT, first0, 0, (char*)F.ldsg + RING_OFF, na);
    }
}
__device__ __forceinline__ void phase_attn_na(Frame& F, const float* rpb  ) {
    const bf16* QKV = (const bf16*)(F.ws + WS_QKV); bf16* O = (bf16*)(F.ws + WS_O);
    float* tab = (float*)((char*)F.ldsg + RING_OFF + att::SHM_ATTN);
    const bool bal = (F.G == 256);
    for (int k = 0;; ++k) {
        int u;
        if (bal) { if (k < 2) u = F.vcu + 256 * k; else { const int q = F.vcu & 15; if (k > 2 || (q != 0 && q != 15)) break; u = 512 + (F.vcu >> 4) * 2 + (q == 15 ? 1 : 0); } }
        else { u = F.vcu + F.G * k; if (u >= 512 + 32) break; }
        int b, h, qrow, NT, second0 = 0; att::NaInfo na{0, 0, tab};
        if (u < 512) {
            b = u >> 8; h = (u >> 4) & 15; const int qb = u & 15; qrow = qb * 256;
            const int r0 = qb * 4; int rs_lo = r0 - 4; rs_lo = rs_lo < 0 ? 0 : (rs_lo > 56 ? 56 : rs_lo); int rs_hi = r0 + 3 - 4; rs_hi = rs_hi < 0 ? 0 : (rs_hi > 56 ? 56 : rs_hi);
            int nlat = rs_hi + 8 - rs_lo;
            if (nlat & 1) { if (rs_hi + 8 < 64) nlat += 1; else { rs_lo -= 1; nlat += 1; } }
            na.r0 = r0; na.rs_lo = rs_lo; NT = 4 + nlat; second0 = rs_lo * 64;
        } else { const int v = u - 512; b = v >> 4; h = v & 15; qrow = SEQ; NT = 4; }
        for (int i = F.tid; i < 15 * 31; i += 512) tab[64 + i] = rpb[h * 465 + i] * (1.0f / att::SCALE);
        __syncthreads();
        const bf16* Qb = QKV + ((size_t)b * SB + qrow) * 6144 + h * HD;
        const bf16* Kh = QKV + (size_t)b * SB * 6144 + 2048 + h * HD; const bf16* Vh = Kh + 2048;
        att::attn_unit_simple<6144, 6144, 2048, true>(Qb, Kh, Vh, O + ((size_t)b * SB + qrow) * D + h * HD, NT, 4, SEQ, second0, (char*)F.ldsg + RING_OFF, na);
    }
}
__device__ __forceinline__ void phase_convfix(Frame& F, const float* cw  , const float* cb  , int lat_only) {
    const float* HALO = (const float*)(F.ws + WS_HALO); bf16* ACT = (bf16*)(F.ws + WS_ACT);
    for (int wi = F.gw; wi < 2 * (M / 64) * 22; wi += F.NGW) {
        const int it = wi / 22, i = wi - it * 22;
        const int g = it >> 1, last = it & 1, row = g * 64 + (last ? 63 : 0);
        int pos, len; const int s_ = row_seqinfo(row, pos, len);
        if (lat_only && s_ == 2) continue;
        const bool hp = pos > 0, hn = pos + 1 < len;
        const float* pm = HALO + (size_t)(last ? g * 4 + 2 : (g - 1) * 4 + 3) * DFF2;
        const float* p0 = HALO + (size_t)(last ? g * 4 + 3 : g * 4 + 0) * DFF2;
        const float* pp = HALO + (size_t)(last ? (g + 1) * 4 + 0 : g * 4 + 1) * DFF2;
        const f32x4 z = {0.f, 0.f, 0.f, 0.f};
        {
            const int f = (i * 64 + F.lane) * 4;
            f32x4 r[2];
#pragma unroll
            for (int half = 0; half < 2; ++half) {
                const int c = f + half * DFF;
                const f32x4 um = hp ? *(const f32x4*)(pm + c) : z, u0 = *(const f32x4*)(p0 + c), up = hn ? *(const f32x4*)(pp + c) : z;
                r[half] = *(const f32x4*)(cb + c) + *(const f32x4*)(cw + c) * um + *(const f32x4*)(cw + DFF2 + c) * u0 + *(const f32x4*)(cw + 2 * DFF2 + c) * up;
            }
            float o[4];
#pragma unroll
            for (int e = 0; e < 4; ++e) o[e] = r[0][e] * r[1][e] * __builtin_amdgcn_rcpf(1.f + __expf(-r[0][e]));
            v2u w; w.x = cvt_pk_bf16(o[0], o[1]); w.y = cvt_pk_bf16(o[2], o[3]);
            *(v2u*)(ACT + (size_t)row * DFF + f) = w;
        }
    }
}

constexpr int PH_PER_LAYER = 12, N_PHASES = 1 + DEPTH * PH_PER_LAYER;
__global__ void __launch_bounds__(512, 2) fwd(Args args) {
    extern __shared__ __attribute__((aligned(16))) unsigned char lds[];
    Frame F;
    F.lds = (LAS unsigned char*)lds; F.ldsg = lds;
    F.tid = threadIdx.x; F.lane = F.tid & 63; F.wave = __builtin_amdgcn_readfirstlane(F.tid >> 6);
    F.G = gridDim.x; { const int bx = blockIdx.x; F.vcu = (F.G % 8 == 0) ? (bx % 8) * (F.G / 8) + bx / 8 : bx; }
    F.gw = F.vcu * 8 + F.wave; F.NGW = F.G * 8;
    F.ws = args.ws; F.in = args.in; F.out = args.out;
    volatile LAS unsigned* MISC = (volatile LAS unsigned*)(F.lds + MISC_OFF);
    for (int u = F.tid; u < (LDS_BYTES - LDSCTL_OFF) / 4; u += 512) ((LAS unsigned*)(F.lds + LDSCTL_OFF))[u] = 0u;
    __syncthreads();
    const int lo = args.ph_lo, hi = args.ph_hi;
    XcdBarrier bar; bar.bar = (unsigned*)(F.ws + WS_CTL) + CW_BAR; bar.x = 0; bar.st = nullptr;
    if (hi - lo > 1) bar = xcd_barrier_post((unsigned*)(F.ws + WS_CTL) + CW_BAR, MISC + 8);
#ifndef PHMASK
#define PHMASK 0xFFFFFFFFu
#endif
#ifndef REPMASK
#define REPMASK 0u
#endif
#define CT(b) ((PHMASK >> (b)) & 1u)
#define NREP(b) (CT(b) ? (((REPMASK >> (b)) & 1u) ? 2 : 1) : 0)
#define REPF(b) for (int rep_ = 0; rep_ < NREP(b); ++rep_)
#define IN(k) (lo <= (k) && (k) < hi)
#define REFRESH() do { F.tid = ltid(); F.lane = F.tid & 63; F.wave = __builtin_amdgcn_readfirstlane(F.tid >> 6); F.gw = F.vcu * 8 + F.wave; } while (0)
#define SEAM(k) do { if (IN((k) + 1)) xcd_barrier(bar); } while (0)
    const float* MOD = (const float*)(F.ws + WS_MOD);
    bf16* X = (bf16*)(F.ws + WS_X);
    bf16* H = (bf16*)(F.ws + WS_H); bf16* Obuf = (bf16*)(F.ws + WS_O);

    if (IN(0)) { REFRESH(); REPF(0) pro_transposes(F); REPF(1) pro_small(F); __syncthreads(); REPF(3) pro_mod(F); SEAM(0); }

    for (int l = 0; l < DEPTH; ++l) {
        const int kind = l % 3, j = l / 3, P = 1 + l * PH_PER_LAYER;
        const float* modl = MOD + (size_t)l * 3 * 12288;
        const int lat3 = (l == DEPTH - 1) ? 1 : 0;
        if (IN(P + 0)) { REFRESH(); REPF(4) phase_norm(F, F.in[6] + (size_t)l * D, modl, H, nullptr, l > 0 ? 11 : 0, modl - 3 * 12288 + 2 * 12288 + 5 * D, 0, l == 0 ? F.in[0] : nullptr, l == 0 ? F.in[2] : nullptr); SEAM(P + 0); }
        if (IN(P + 1)) { REFRESH();
            if (kind == 0) { REPF(5) phase_xm(F, F.in[12] + (size_t)j * 6 * D); }
            else REPF(6) {
                pg8::Gemm g{H, (const bf16*)(F.ws + (kind == 1 ? WS_NAQKVT : WS_GAQKVT)), D};
                pg8::MultiOrder S{&g_ord[kind == 1 ? ORD_N24 : ORD_N12], NMB, F.G, (int)blockIdx.x, 0, 32};
                EpiQKV E{(bf16*)(F.ws + WS_QKV), kind == 1 ? 6144 : 3072, kind == 1 ? 16 : 10, 8, F.in[kind == 1 ? 32 : 37], F.in[kind == 1 ? 33 : 38], kind == 1 ? 0 : 1,
                         (LAS float*)(F.lds + LDSCTL_OFF + 512)};
                pg8::gemm_phase<EpiQKV, pg8::MultiOrder, true, true>(F.lds + RING_OFF, g, S, E);
            }
            SEAM(P + 1);
        }
        if (IN(P + 2) && kind == 0) { REFRESH();
            if (kind == 0) { REPF(7) {
                pg8::Gemm g{(const bf16*)(F.ws + WS_XM), (const bf16*)(F.ws + WS_RWT) + (size_t)j * 28 * 256 * 2048, D};
                pg8::MultiOrder S{&g_ord[j == 0 ? ORD_RW0 : ORD_RW1], NMB, F.G, (int)blockIdx.x, 0, 32};
                EpiGen E{F.ws, g_od[j == 0 ? OD_RW0 : OD_RW1], F.in};
                pg8::gemm_phase<EpiGen, pg8::MultiOrder, true, true>(F.lds + RING_OFF, g, S, E); }
            }
            SEAM(P + 2);
        }
        if (IN(P + 3)) { REFRESH();
            if (kind == 0) { REPF(10) {
                pg8::Gemm g{(const bf16*)(F.ws + WS_L1O), (const bf16*)(F.ws + WS_RL2T) + (size_t)j * 48 * 256 * 256, 256};
                pg8::MultiOrder S{&g_ord[j == 0 ? ORD_L20 : ORD_L21], NMB, F.G, (int)blockIdx.x, 0, 4};
                EpiGen E{F.ws, g_od[j == 0 ? OD_L20 : OD_L21], F.in};
                pg8::gemm_phase<EpiGen, pg8::MultiOrder, true, true>(F.lds + RING_OFF, g, S, E); }
                REFRESH(); phase_rs(F, j);
            } else if (kind == 1) { REPF(11) phase_attn_na(F, F.in[34]); }
            else { REPF(12) phase_attn_gqa(F); }
            SEAM(P + 3);
        }
        if (kind == 0) {
            const bf16* Vsrc = (const bf16*)(F.ws + (j == 0 ? WS_V0 : WS_RKV + 2 * SZ_ACT));

            if (IN(P + 5)) { REFRESH(); REPF(14) phase_scanfused(F, j, Vsrc); SEAM(P + 5); }
            if (IN(P + 6)) { REFRESH(); REPF(15) phase_readout(F, j, j == 0 ? Vsrc : (const bf16*)(F.ws + WS_VF), lat3); SEAM(P + 6); }
        }
        if (IN(P + 7)) { REFRESH(); if (CT(16)) {
            const size_t wo = (kind == 0) ? (WS_RWOT + (size_t)j * 2048 * 2048 * 2) : (kind == 1 ? WS_NAOT : WS_GAOT);
            pg8::Gemm g{Obuf, (const bf16*)(F.ws + wo), D};
            pg8::SplitCtxOrder S{F.G, (int)blockIdx.x, 32, 8, 4, lat3 ? 0 : 1};
            EpiRes E{X, modl + 2 * D, nullptr, (float*)(F.ws + WS_PART), (l == 0) ? F.in[0] : nullptr};
            pg8::gemm_phase<EpiRes, pg8::SplitCtxOrder, true, true>(F.lds + RING_OFF, g, S, E); }
            SEAM(P + 7);
        }
        if (IN(P + 8)) { REFRESH(); REPF(4) phase_norm(F, F.in[7] + (size_t)l * D, modl + 3 * D, H, nullptr, lat3 ? 0 : 8, modl + 2 * 12288 + 2 * D, lat3); SEAM(P + 8); }
        if (IN(P + 9)) { REFRESH(); REPF(17) {
            pg8::Gemm g{H, (const bf16*)(F.ws + WS_UPT) + (size_t)l * DFF2 * D, D};
            pg8::MultiOrder S{&g_ord[ORD_N44], NMB, F.G, (int)blockIdx.x, lat3, 32};
            EpiUp E{(bf16*)(F.ws + WS_ACT), (float*)(F.ws + WS_HALO), F.in[9] + (size_t)l * 3 * DFF2, F.in[10] + (size_t)l * DFF2};
            pg8::gemm_phase<EpiUp, pg8::MultiOrder, true, true>(F.lds + RING_OFF, g, S, E); }
            SEAM(P + 9);
        }
        if (IN(P + 10)) { REFRESH(); REPF(18) phase_convfix(F, F.in[9] + (size_t)l * 3 * DFF2, F.in[10] + (size_t)l * DFF2, lat3); SEAM(P + 10); }
        if (IN(P + 11)) { REFRESH(); if (CT(19)) {
            pg8::Gemm g{(const bf16*)(F.ws + WS_ACT), (const bf16*)(F.ws + WS_DNT) + (size_t)l * D * DFF, DFF};
            pg8::SplitCtxOrder S{F.G, (int)blockIdx.x, 88, 11, 8, lat3 ? 0 : 1};
            EpiRes E{X, modl + 5 * D, (l == DEPTH - 1) ? F.out : nullptr, (float*)(F.ws + WS_PART), nullptr};
            pg8::gemm_phase<EpiRes, pg8::SplitCtxOrder, true, true>(F.lds + RING_OFF, g, S, E); }
            SEAM(P + 11);
        }
    }
#undef IN
#undef SEAM
}

extern "C" void kernel_launch(void* const* d_in, const int* in_sizes, int n_in, void* d_out, int out_size, void* d_ws, size_t ws_size, hipStream_t stream) {
    static int grid = 0;
    if (grid == 0) {
        if (n_in != 40 || out_size != NB * SEQ * D || ws_size < WS_END) { fprintf(stderr, "kernel_launch: unexpected shapes (n_in %d out %d ws %zu need %zu)\n", n_in, out_size, ws_size, (size_t)WS_END); grid = -1; return; }
        int dev = 0, cus = 0;
        if (hipGetDevice(&dev) != hipSuccess || hipDeviceGetAttribute(&cus, hipDeviceAttributeMultiprocessorCount, dev) != hipSuccess) { grid = -1; return; }
        if (hipFuncSetAttribute((const void*)fwd, hipFuncAttributeMaxDynamicSharedMemorySize, LDS_BYTES) != hipSuccess) { fprintf(stderr, "kernel_launch: hipFuncSetAttribute failed\n"); grid = -1; return; }
        int per_cu = 0;
        if (hipOccupancyMaxActiveBlocksPerMultiprocessor(&per_cu, (const void*)fwd, 512, LDS_BYTES) != hipSuccess || per_cu < 1) fprintf(stderr, "kernel_launch: occupancy query says %d\n", per_cu);
        (void)hipGetLastError();
        grid = cus;
    }
    if (grid < 0) return;
    (void)hipMemsetAsync((char*)d_ws + WS_CTL, 0, CTL_ZERO_BYTES, stream);
    Args a{};
    for (int i = 0; i < 40; ++i) a.in[i] = (const float*)d_in[i];
    a.out = (float*)d_out; a.ws = (unsigned char*)d_ws;
#if MK_ONE_LAUNCH
    a.ph_lo = 0; a.ph_hi = N_PHASES;
    hipLaunchKernelGGL(fwd, dim3(grid), dim3(512), LDS_BYTES, stream, a);
#else
    for (int ph = 0; ph < N_PHASES; ++ph) {
        if (ph > 0) { const int l = (ph - 1) / PH_PER_LAYER, k = (ph - 1) % PH_PER_LAYER, kind = l % 3, j = l / 3;
            if (kind != 0 && (k == 4 || k == 5 || k == 6)) continue;
            if (kind == 0 && k == 4) continue; }
        a.ph_lo = ph; a.ph_hi = ph + 1;
        hipLaunchKernelGGL(fwd, dim3(grid), dim3(512), LDS_BYTES, stream, a);
    }
#endif
    const hipError_t le = hipPeekAtLastError();
    if (le != hipSuccess) fprintf(stderr, "kernel_launch: launch failed: %s\n", hipGetErrorName(le));
}
```

```cpp
#include <hip/hip_runtime.h>
#include <cstdio>
#include <cstdint>

#ifndef MK_ONE_LAUNCH
#define MK_ONE_LAUNCH 1
#endif

constexpr int D = 2048, NB = 2, SEQ = 4096, CTXL = 256, DEPTH = 4;
constexpr int SB = SEQ + CTXL;
constexpr int M = NB * SB;
constexpr int NMB = M / 256;
constexpr int DFF = 5632, DFF2 = 11264;
constexpr int HD = 128, NH = 16, KVH = 4, KVD = 512;
constexpr int RNH = 32;
constexpr float NORM_EPS = 1e-6f, GN_EPS = 64e-5f;

#define GAS __attribute__((address_space(1)))
#define LAS __attribute__((address_space(3)))
typedef unsigned short bf16;
typedef unsigned v4u __attribute__((ext_vector_type(4)));
typedef unsigned v2u __attribute__((ext_vector_type(2)));
typedef float f32x4 __attribute__((ext_vector_type(4)));
typedef float f32x2 __attribute__((ext_vector_type(2)));
typedef short bf16x8 __attribute__((ext_vector_type(8)));

__device__ __forceinline__ int ltid() { int t = threadIdx.x; asm volatile("" : "+v"(t)); return t; }
__device__ __forceinline__ float bflo(unsigned u) { return __uint_as_float(u << 16); }
__device__ __forceinline__ float bfhi(unsigned u) { return __uint_as_float(u & 0xffff0000u); }
__device__ __forceinline__ unsigned cvt_pk_bf16(float lo, float hi) { unsigned r; asm volatile("v_cvt_pk_bf16_f32 %0, %1, %2" : "=v"(r) : "v"(lo), "v"(hi)); return r; }
typedef __bf16 bf16x2_t __attribute__((ext_vector_type(2)));
__device__ __forceinline__ unsigned cvt_pk_bf16_v(float lo, float hi) { const f32x2 v = {lo, hi}; return __builtin_bit_cast(unsigned, __builtin_convertvector(v, bf16x2_t)); }
__device__ __forceinline__ float sigmoidf_(float x) { return __builtin_amdgcn_rcpf(1.0f + __expf(-x)); }
__device__ __forceinline__ float wave_sum(float v) {
#pragma unroll
    for (int o = 1; o < 64; o <<= 1) v += __shfl_xor(v, o);
    return v;
}
template <int CTRL> __device__ __forceinline__ float dppmov(float v) { return __builtin_bit_cast(float, __builtin_amdgcn_update_dpp(0, __builtin_bit_cast(int, v), CTRL, 0xF, 0xF, true)); }
__device__ __forceinline__ float sum16(float v) {
    v += dppmov<0xB1>(v); v += dppmov<0x4E>(v); v += dppmov<0x141>(v); v += dppmov<0x140>(v); return v;
}

constexpr size_t MiB = 1u << 20;
constexpr size_t WS_CTL = 0, CTL_ZERO_BYTES = 1 * MiB;
constexpr size_t WS_MOD = 1 * MiB;
constexpr size_t WS_X = 2 * MiB;
constexpr size_t WS_H = 70 * MiB;
constexpr size_t WS_O = 104 * MiB;
constexpr size_t WS_V0 = 138 * MiB;
constexpr size_t WS_UPT = 172 * MiB;
constexpr size_t WS_DNT = 348 * MiB;
constexpr size_t WS_RWT = 436 * MiB;
constexpr size_t WS_RL2T = 492 * MiB;
constexpr size_t WS_RWOT = 504 * MiB;
constexpr size_t WS_NAQKVT = 520 * MiB;
constexpr size_t WS_NAOT = 544 * MiB;
constexpr size_t WS_GAQKVT = 552 * MiB;
constexpr size_t WS_GAOT = 564 * MiB;
constexpr size_t WS_S0 = 572 * MiB;
constexpr size_t WS_RKV = WS_S0;
constexpr size_t WS_L1O = WS_S0 + 102 * MiB;
constexpr size_t WS_DEC = WS_S0 + 119 * MiB;
constexpr size_t WS_AA = WS_S0 + 255 * MiB;
constexpr size_t WS_GG = WS_S0 + 323 * MiB;
constexpr size_t WS_VG = WS_S0 + 357 * MiB;
constexpr size_t WS_PART = WS_S0 + 391 * MiB;
constexpr size_t WS_Y = WS_S0 + 435 * MiB;
constexpr size_t WS_XM = WS_S0 + 571 * MiB;
constexpr size_t WS_OPS = WS_S0 + 571 * MiB;
constexpr size_t WS_BON = WS_S0 + 435 * MiB + 72 * MiB;
constexpr size_t WS_H32 = WS_DEC;
constexpr size_t WS_QKV = WS_S0;
constexpr size_t WS_ACT = WS_S0 + 188 * MiB;
constexpr size_t WS_HALO = WS_S0 + 282 * MiB;
constexpr size_t WS_END = WS_S0 + 945 * MiB;
constexpr size_t SZ_ACT = (size_t)M * D * 2;

namespace pg8 {
#define PG8_LAS __attribute__((address_space(3)))
typedef unsigned short bf16_t;
typedef unsigned u32x4 __attribute__((ext_vector_type(4)));
constexpr int BM = 256, BK = 64, HALF = 128, HTB = HALF * BK * 2, STAGE_BYTES = 8 * HTB, NXCD = 8, WGM = 4;

__host__ __device__ __forceinline__ int lds_byte(int r, int c) { const int st = (r >> 4) * 2 + (c >> 5), rr = r & 15, cc = c & 31, ob = rr * 64 + cc * 2; return st * 1024 + (ob ^ (((ob >> 9) & 1) << 5)); }
__host__ __device__ __forceinline__ void stage_rc(int b, int& R, int& C) { const int st = b / 1024, sb = b % 1024, swz = sb ^ (((sb >> 9) & 1) << 5); R = (st >> 1) * 16 + swz / 64; C = (st & 1) * 32 + (swz % 64) / 2; }
__host__ __device__ __forceinline__ int perm32(int rho) { const int n = rho >> 4, i = rho & 15; return 8 * (i >> 2) + 4 * n + (i & 3); }

struct Unit { int pm, pn, lm, ln, sub, kofs, nt, kpart; };
struct Gemm { const bf16_t* A; const bf16_t* Bt; int K; };

struct SubP { int nN, pmBase, pnBase, cum; };
struct OrdTab { int nsub, total, pad0, pad1; SubP sp[8]; };

struct MultiOrder {
    const OrdTab* T; int nM, G, c, lat_only, nt;
    __device__ __forceinline__ bool next(int i, Unit& u) const {
        const int total = lat_only ? T->total / 34 * 32 : T->total;
        const long L = (long)i * G + c; if (L >= total) return false;
        int w = (int)L; { const int q = total / NXCD, r = total % NXCD, xcd = w % NXCD, off = w / NXCD; w = (xcd < r ? xcd * (q + 1) : r * (q + 1) + (xcd - r) * q) + off; }
        int s = 0; const int ns = T->nsub; const int nMe = lat_only ? 32 : nM;
        if (lat_only) { while (s + 1 < ns && w >= T->sp[s + 1].cum / 34 * 32) ++s; }
        else { while (s + 1 < ns && w >= T->sp[s + 1].cum) ++s; }
        const int lw = w - (lat_only ? T->sp[s].cum / 34 * 32 : T->sp[s].cum), nN = T->sp[s].nN;
        const int nig = WGM * nN, gid = lw / nig, fm = gid * WGM, gsz = (nMe - fm) < WGM ? (nMe - fm) : WGM;
        int lm = fm + ((lw % nig) % gsz); const int ln = (lw % nig) / gsz;
        if (lat_only) lm += (lm >= 16) ? 1 : 0;
        u.lm = lm; u.ln = ln; u.sub = s; u.pm = T->sp[s].pmBase + lm; u.pn = T->sp[s].pnBase + ln; u.kofs = 0; u.nt = nt; u.kpart = -1; return true;
    }
};
struct Lora2Order {
    const OrdTab* T; int nM, G, c;
    __device__ __forceinline__ bool next(int i, Unit& u) const {
        const int total = T->total;
        const long L = (long)i * G + c; if (L >= total) return false;
        const int xcd = (int)L % NXCD, off = (int)L / NXCD;
        int s = 0; const int ns = T->nsub;
        while (s + 1 < ns && off >= T->sp[s + 1].cum / NXCD) ++s;
        const int ns8 = ((s + 1 < ns ? T->sp[s + 1].cum : total) - T->sp[s].cum) / NXCD;
        const int lw = xcd * ns8 + (off - T->sp[s].cum / NXCD), nN = T->sp[s].nN;
        const int nig = WGM * nN, gid = lw / nig, fm = gid * WGM, gsz = (nM - fm) < WGM ? (nM - fm) : WGM;
        const int lm = fm + ((lw % nig) % gsz), ln = (lw % nig) / gsz;
        u.lm = lm; u.ln = ln; u.sub = s; u.pm = T->sp[s].pmBase + lm; u.pn = T->sp[s].pnBase + ln; u.kpart = -1;
        u.kofs = (s < 2) ? (ln >> 3) * 128 : 0; u.nt = (s == 2) ? 4 : 2;
        return true;
    }
};
struct BlockOrder {
    int G, c, lat_only, nt;
    __device__ __forceinline__ bool next(int i, Unit& u) const {
        const int nr = lat_only ? 16 : 17, per = nr * 11;
        const long L = (long)i * G + c; if (L >= (long)NXCD * per) return false;
        const int xcd = (int)(L % NXCD), off = (int)(L / NXCD);
        const int bx = xcd >> 2, by = xcd & 3;
        const int nig = WGM * 11, gid = off / nig, fm = gid * WGM, gsz = (nr - fm) < WGM ? (nr - fm) : WGM;
        const int rg = off % nig;
        const int lr = fm + (gsz == WGM ? (rg & (WGM - 1)) : 0), lc = gsz == WGM ? (rg >> 2) : rg;
        int lm = bx * nr + lr; if (lat_only) lm += (lm >= 16) ? 1 : 0;
        const int ln = by * 11 + lc;
        u.lm = lm; u.ln = ln; u.sub = 0; u.pm = lm; u.pn = ln; u.kofs = 0; u.nt = nt; u.kpart = -1;
        return true;
    }
};
struct SplitCtxOrder {
    int G, c, ntFull, KS, ntPart, with_ctx;
    __device__ __forceinline__ bool next(int i, Unit& u) const {
        const long L = (long)i * G + c; const int nfull = 256, total = nfull + (with_ctx ? 16 * KS : 0);
        if (L >= total) return false;
        int w = (int)L; u.sub = 0;
        if (w < nfull) {
            { const int q = nfull / NXCD, xcd = w % NXCD, off = w / NXCD; w = xcd * q + off; }
            const int nig = WGM * 8, gid = w / nig, fm = gid * WGM; const int lml = fm + ((w % nig) % WGM); u.ln = (w % nig) / WGM;
            u.lm = lml + (lml >= 16 ? 1 : 0); u.kofs = 0; u.nt = ntFull; u.kpart = -1;
        } else {
            w -= nfull; const int kp = w % KS, t = w / KS;
            u.lm = (t >> 3) ? 33 : 16; u.ln = t & 7; u.kofs = kp * ntPart * BK; u.nt = ntPart; u.kpart = kp;
        }
        u.pm = u.lm; u.pn = u.ln; return true;
    }
};

template <class Epi, class Sched, bool ALIGN_EPI = false, bool SP2 = false>
__device__ __forceinline__ void gemm_phase(PG8_LAS unsigned char* lds, const Gemm g, const Sched& S, const Epi& E) {
    const int tid = ltid(), wid = __builtin_amdgcn_readfirstlane(tid >> 6), lane = tid & 63, wr = wid >> 2, wc = wid & 3, fr = lane & 15, fq = lane >> 4;
    int K = g.K; asm volatile("" : "+s"(K));
    unsigned voffA[2], voffB[2];
#pragma unroll
    for (int i = 0; i < 2; ++i) { int R, C; stage_rc(tid * 16 + i * 8192, R, C); const int Rb = Epi::PERM ? ((R & ~31) + perm32(R & 31)) : R;
        voffA[i] = (unsigned)(R * K + C) * 2u; voffB[i] = (unsigned)(Rb * K + C) * 2u; }
    const size_t kstep = (size_t)(BK * 2);
    const size_t hstep = (size_t)HALF * K * 2;
    const size_t tstep = 2 * hstep;
    const unsigned ldsw = (unsigned)wid * 1024u;
    const int aoff = lds_byte(wr * 64 + fr, fq * 8), boff = lds_byte(wc * 32 + fr, fq * 8);
#define PG8_SA(b, h) (((b) * 2 + (h)) * HTB)
#define PG8_SB(b, h) ((4 + (b) * 2 + (h)) * HTB)
#define PG8_STAGE(bufoff, gbase, voff) do { _Pragma("unroll") for (int _i = 0; _i < 2; ++_i) \
        __builtin_amdgcn_global_load_lds((const unsigned*)((const char*)(gbase) + (voff)[_i]), (PG8_LAS unsigned*)(lds + (bufoff) + ldsw + _i * 8192), 16, 0, 0); } while (0)
#define PG8_LDA(dst, b, h) do { _Pragma("unroll") for (int m = 0; m < 4; ++m) _Pragma("unroll") for (int k = 0; k < 2; ++k) dst[m][k] = *(const PG8_LAS bf16x8*)(lds + PG8_SA(b, h) + aoff + m * 2048 + k * 1024); } while (0)
#define PG8_LDB(dst, b, h) do { _Pragma("unroll") for (int n = 0; n < 2; ++n) _Pragma("unroll") for (int k = 0; k < 2; ++k) dst[n][k] = *(const PG8_LAS bf16x8*)(lds + PG8_SB(b, h) + boff + n * 2048 + k * 1024); } while (0)
#define PG8_MMA(ai, bj, At, Bt) do { __builtin_amdgcn_s_setprio(1); _Pragma("unroll") for (int m = 0; m < 4; ++m) _Pragma("unroll") for (int n = 0; n < 2; ++n) _Pragma("unroll") for (int k = 0; k < 2; ++k) \
        acc[ai][bj][m][n] = __builtin_amdgcn_mfma_f32_16x16x32_bf16(Bt[n][k], At[m][k], acc[ai][bj][m][n], 0, 0, 0); __builtin_amdgcn_s_setprio(0); } while (0)
#define PG8_WAIT_V(n) asm volatile("s_waitcnt vmcnt(" #n ")" ::: "memory")
#define PG8_WAIT_VF_(nf) asm volatile("s_cmp_eq_u32 %0, 0\n\ts_cbranch_scc1 .LW%=\n\ts_waitcnt vmcnt(" #nf ")\n\ts_branch .LE%=\n.LW%=:\n\ts_waitcnt vmcnt(8)\n.LE%=:" :: "s"(fresh) : "memory", "scc")
#define PG8_WAIT_VF(n16, n8) do { if constexpr (Epi::MIN_VM == 16) PG8_WAIT_VF_(n16); else if constexpr (Epi::MIN_VM == 8) PG8_WAIT_VF_(n8); else PG8_WAIT_V(8); } while (0)
#define PG8_WAIT_L(n) asm volatile("s_waitcnt lgkmcnt(" #n ")" ::: "memory")
#define PG8_BAR __builtin_amdgcn_s_barrier()
#define PG8_SCHED __builtin_amdgcn_sched_barrier(0)
    Unit cur, nxt; int ui = 0;
    if (!S.next(0, cur)) return;
    f32x4 acc[2][2][4][2];
#pragma unroll
    for (int a = 0; a < 2; ++a)
#pragma unroll
        for (int b = 0; b < 2; ++b)
#pragma unroll
            for (int m = 0; m < 4; ++m)
#pragma unroll
                for (int n = 0; n < 2; ++n) acc[a][b][m][n] = (f32x4){0.f, 0.f, 0.f, 0.f};
    bf16x8 At[4][2], B0[2][2], B1[2][2];
    const char* cA = (const char*)g.A + (size_t)cur.pm * tstep + (size_t)cur.kofs * 2; const char* cB = (const char*)g.Bt + (size_t)cur.pn * tstep + (size_t)cur.kofs * 2;
    if constexpr (SP2) {
        PG8_STAGE(PG8_SB(0, 0), cB, voffB); PG8_STAGE(PG8_SB(0, 1), cB + hstep, voffB); PG8_STAGE(PG8_SA(0, 0), cA, voffA); PG8_STAGE(PG8_SA(0, 1), cA + hstep, voffA);
        if (wr == 1) PG8_BAR;
        PG8_WAIT_V(2); PG8_BAR;
        PG8_STAGE(PG8_SB(1, 0), cB + kstep, voffB); PG8_STAGE(PG8_SA(1, 0), cA + kstep, voffA); PG8_STAGE(PG8_SB(1, 1), cB + hstep + kstep, voffB);
        PG8_WAIT_V(6); PG8_BAR;
    } else {
        PG8_STAGE(PG8_SB(0, 0), cB, voffB); PG8_STAGE(PG8_SA(0, 0), cA, voffA); PG8_STAGE(PG8_SB(0, 1), cB + hstep, voffB); PG8_STAGE(PG8_SA(0, 1), cA + hstep, voffA);
        if (wr == 1) PG8_BAR;
        PG8_WAIT_V(4); PG8_BAR;
        PG8_STAGE(PG8_SB(1, 0), cB + kstep, voffB); PG8_STAGE(PG8_SA(1, 0), cA + kstep, voffA); PG8_STAGE(PG8_SB(1, 1), cB + hstep + kstep, voffB);
        PG8_WAIT_V(6); PG8_BAR;
    }
    for (;;) {
        const bool has_next = S.next(ui + 1, nxt);
        const char* nA = has_next ? (const char*)g.A + (size_t)nxt.pm * tstep + (size_t)nxt.kofs * 2 : cA; const char* nB = has_next ? (const char*)g.Bt + (size_t)nxt.pn * tstep + (size_t)nxt.kofs * 2 : cB;
        const int nt = cur.nt;
        for (int t = 0; t < nt; t += 2) {
            const bool last = (t == nt - 2);
            const char* a1 = cA + (size_t)(t + 1) * kstep;
            const char* a2 = last ? nA : cA + (size_t)(t + 2) * kstep; const char* b2 = last ? nB : cB + (size_t)(t + 2) * kstep;
            const char* a3 = a2 + kstep; const char* b3 = b2 + kstep;
            if constexpr (SP2) {
            const int fresh = __builtin_amdgcn_readfirstlane(((Epi::MIN_VM > 0) && (t == 0) && (ui > 0)) ? 1 : 0);
            PG8_LDB(B0, 0, 0); PG8_LDB(B1, 0, 1); PG8_SCHED; PG8_LDA(At, 0, 0); PG8_STAGE(PG8_SA(1, 1), a1 + hstep, voffA);
            PG8_WAIT_VF(26, 18); PG8_WAIT_L(0); PG8_BAR; PG8_MMA(0, 0, At, B0); PG8_MMA(0, 1, At, B1); PG8_BAR; PG8_SCHED;
            PG8_LDA(At, 0, 1); PG8_STAGE(PG8_SB(0, 0), b2, voffB); PG8_STAGE(PG8_SB(0, 1), b2 + hstep, voffB); PG8_STAGE(PG8_SA(0, 0), a2, voffA);
            PG8_WAIT_VF(26, 18); PG8_WAIT_L(0); PG8_BAR; PG8_MMA(1, 0, At, B0); PG8_MMA(1, 1, At, B1); PG8_BAR; PG8_SCHED;
            PG8_LDB(B0, 1, 0); PG8_LDB(B1, 1, 1); PG8_SCHED; PG8_LDA(At, 1, 0); PG8_STAGE(PG8_SA(0, 1), a2 + hstep, voffA);
            PG8_WAIT_VF(26, 18); PG8_WAIT_L(0); PG8_BAR; PG8_MMA(0, 0, At, B0); PG8_MMA(0, 1, At, B1); PG8_BAR; PG8_SCHED;
            PG8_LDA(At, 1, 1); PG8_STAGE(PG8_SB(1, 0), b3, voffB); PG8_STAGE(PG8_SB(1, 1), b3 + hstep, voffB); PG8_STAGE(PG8_SA(1, 0), a3, voffA);
            PG8_WAIT_VF(32, 24); PG8_WAIT_L(0); PG8_BAR; PG8_MMA(1, 0, At, B0); PG8_MMA(1, 1, At, B1); PG8_BAR; PG8_SCHED;
            } else {
            PG8_LDB(B0, 0, 0); PG8_SCHED; PG8_LDA(At, 0, 0); PG8_STAGE(PG8_SA(1, 1), a1 + hstep, voffA);
            PG8_WAIT_L(8); PG8_BAR; PG8_WAIT_L(0); PG8_MMA(0, 0, At, B0); PG8_BAR; PG8_SCHED;
            PG8_LDB(B1, 0, 1); PG8_STAGE(PG8_SB(0, 0), b2, voffB);
            PG8_BAR; PG8_WAIT_L(0); PG8_MMA(0, 1, At, B1); PG8_BAR;
            PG8_LDA(At, 0, 1); PG8_STAGE(PG8_SA(0, 0), a2, voffA);
            PG8_BAR; PG8_WAIT_L(0); PG8_MMA(1, 0, At, B0); PG8_BAR; PG8_SCHED;
            PG8_STAGE(PG8_SB(0, 1), b2 + hstep, voffB);
            PG8_WAIT_V(6); PG8_BAR; PG8_MMA(1, 1, At, B1); PG8_BAR;
            PG8_LDB(B0, 1, 0); PG8_SCHED; PG8_LDA(At, 1, 0); PG8_STAGE(PG8_SA(0, 1), a2 + hstep, voffA);
            PG8_WAIT_L(8); PG8_BAR; PG8_WAIT_L(0); PG8_MMA(0, 0, At, B0); PG8_BAR; PG8_SCHED;
            PG8_LDB(B1, 1, 1); PG8_STAGE(PG8_SB(1, 0), b3, voffB);
            PG8_BAR; PG8_WAIT_L(0); PG8_MMA(0, 1, At, B1); PG8_BAR;
            PG8_LDA(At, 1, 1); PG8_STAGE(PG8_SA(1, 0), a3, voffA);
            PG8_BAR; PG8_WAIT_L(0); PG8_MMA(1, 0, At, B0); PG8_BAR; PG8_SCHED;
            PG8_STAGE(PG8_SB(1, 1), b3 + hstep, voffB);
            PG8_WAIT_V(6); PG8_BAR; PG8_MMA(1, 1, At, B1); PG8_BAR;
            }
        }
        if constexpr (SP2 && Epi::MIN_VM > 0) { if (has_next) PG8_STAGE(PG8_SA(1, 1), nA + kstep + hstep, voffA); }
        if constexpr (ALIGN_EPI) { if (wr == 0) PG8_BAR; }
        E(acc, cur, wr, wc, fr, fq);
        if (!has_next) break;
#pragma unroll
        for (int a = 0; a < 2; ++a)
#pragma unroll
            for (int b = 0; b < 2; ++b)
#pragma unroll
                for (int m = 0; m < 4; ++m)
#pragma unroll
                    for (int n = 0; n < 2; ++n) acc[a][b][m][n] = (f32x4){0.f, 0.f, 0.f, 0.f};
        cur = nxt; cA = nA; cB = nB; ++ui;
        if constexpr (ALIGN_EPI) { if (wr == 1) PG8_BAR; }
    }
    PG8_WAIT_V(0);
    if constexpr (!ALIGN_EPI) { if (wr == 0) PG8_BAR; }
    PG8_BAR;
#undef PG8_SA
#undef PG8_SB
#undef PG8_STAGE
#undef PG8_LDA
#undef PG8_LDB
#undef PG8_MMA
#undef PG8_WAIT_V
#undef PG8_WAIT_VF
#undef PG8_WAIT_VF_
#undef PG8_WAIT_L
#undef PG8_BAR
#undef PG8_SCHED
}
}

enum { ORD_RW0 = 0, ORD_RW1, ORD_L20, ORD_L21, ORD_N8, ORD_N24, ORD_N12, ORD_N44, ORD_N };
#define SUBS1(n) {1, 34 * (n), 0, 0, {{(n), 0, 0, 0}, {0,0,0,0},{0,0,0,0},{0,0,0,0},{0,0,0,0},{0,0,0,0},{0,0,0,0},{0,0,0,0}}}
__constant__ pg8::OrdTab g_ord[ORD_N] = {
    {6, 34 * 27, 0, 0, {{8, 0, 0, 0}, {8, 34, 8, 34 * 8}, {8, 68, 16, 34 * 16}, {1, 102, 24, 34 * 24}, {1, 136, 25, 34 * 25}, {1, 170, 26, 34 * 26}, {0,0,0,0}, {0,0,0,0}}},
    {7, 34 * 28, 0, 0, {{8, 0, 0, 0}, {8, 34, 8, 34 * 8}, {8, 68, 16, 34 * 16}, {1, 102, 24, 34 * 24}, {1, 136, 25, 34 * 25}, {1, 170, 26, 34 * 26}, {1, 68, 27, 34 * 27}, {0,0,0,0}}},
    {3, 34 * 40, 1, 0, {{16, 0, 0, 0}, {16, 34, 16, 34 * 16}, {8, 68, 32, 34 * 32}, {0,0,0,0},{0,0,0,0},{0,0,0,0},{0,0,0,0},{0,0,0,0}}},
    {4, 34 * 48, 1, 0, {{16, 0, 0, 0}, {16, 34, 16, 34 * 16}, {8, 68, 32, 34 * 32}, {8, 102, 40, 34 * 40}, {0,0,0,0},{0,0,0,0},{0,0,0,0},{0,0,0,0}}},
    SUBS1(8), SUBS1(24), SUBS1(12), SUBS1(44)
};
struct OutDesc { unsigned long long off; int ldc, mode, nsplit; unsigned long long split_stride; int bias_in, bias_off; };
enum { OD_RW0 = 0, OD_RW1, OD_L20, OD_L21, OD_NAQKV, OD_GAQKV, OD_UP, OD_N };
#define ODZ {0, 0, 0, 1, 0, -1, 0}
__constant__ OutDesc g_od[OD_N][8] = {
    { {WS_RKV, 2048, 0, 1 << 20, 0, -1, 0}, {WS_RKV + SZ_ACT, 2048, 0, 1 << 20, 0, -1, 0}, {WS_V0, 2048, 0, 1 << 20, 0, -1, 0},
      {WS_L1O, 256, 1, 1 << 20, 0, -1, 0}, {WS_L1O + (size_t)M * 512, 256, 0, 1 << 20, 0, -1, 0}, {WS_L1O + (size_t)M * 1024, 256, 2, 1 << 20, 0, -1, 0}, ODZ, ODZ },
    { {WS_RKV, 2048, 0, 1 << 20, 0, -1, 0}, {WS_RKV + SZ_ACT, 2048, 0, 1 << 20, 0, -1, 0}, {WS_RKV + 2 * SZ_ACT, 2048, 0, 1 << 20, 0, -1, 0},
      {WS_L1O, 256, 1, 1 << 20, 0, -1, 0}, {WS_L1O + (size_t)M * 512, 256, 0, 1 << 20, 0, -1, 0}, {WS_L1O + (size_t)M * 1024, 256, 2, 1 << 20, 0, -1, 0},
      {WS_L1O + (size_t)M * 1536, 256, 0, 1 << 20, 0, -1, 0}, ODZ },
    { {WS_DEC, 2048, 4, 8, (unsigned long long)M * 2048, 14, 0}, {WS_AA, 2048, 3, 8, (unsigned long long)M * 2048, 17, 0}, {WS_GG, 2048, 0, 1 << 20, 0, -1, 0}, ODZ, ODZ, ODZ, ODZ, ODZ },
    { {WS_DEC, 2048, 4, 8, (unsigned long long)M * 2048, 14, 4096}, {WS_AA, 2048, 3, 8, (unsigned long long)M * 2048, 17, 4096}, {WS_GG, 2048, 0, 1 << 20, 0, -1, 0},
      {WS_VG, 2048, 3, 1 << 20, 0, 28, 0}, ODZ, ODZ, ODZ, ODZ },
    { {WS_QKV, 6144, 0, 1 << 20, 0, -1, 0}, ODZ, ODZ, ODZ, ODZ, ODZ, ODZ, ODZ },
    { {WS_QKV, 3072, 0, 1 << 20, 0, -1, 0}, ODZ, ODZ, ODZ, ODZ, ODZ, ODZ, ODZ },
    { {WS_QKV, 11264, 0, 1 << 20, 0, -1, 0}, ODZ, ODZ, ODZ, ODZ, ODZ, ODZ, ODZ },
};

struct Args { const float* in[40]; float* out; unsigned char* ws; int ph_lo, ph_hi; };

struct EpiGen {
    static constexpr bool PERM = true; static constexpr int MIN_VM = 16;
    unsigned char* ws; const OutDesc* od; const float* const* in;
    __device__ __forceinline__ void operator()(const f32x4 (&acc)[2][2][4][2], const pg8::Unit& u, int wr, int wc, int fr, int fq) const {
        const OutDesc* d = od + u.sub;
        const int ldc = d->ldc, mode = d->mode, nsplit = d->nsplit;
        const int sp = u.ln / nsplit, lnl = u.ln - sp * nsplit;
        const int row0 = u.lm * 256 + wr * 64 + fr, col0 = lnl * 256 + wc * 32 + 8 * fq, bcol0 = u.ln * 256 + wc * 32 + 8 * fq;
        unsigned char* base = ws + d->off;
        const size_t esplit = (size_t)sp * d->split_stride;
        const float* bias = (d->bias_in >= 0) ? (in[d->bias_in] + d->bias_off) : nullptr;
        f32x4 bv[2][2];
#pragma unroll
        for (int bj = 0; bj < 2; ++bj)
#pragma unroll
            for (int n = 0; n < 2; ++n) bv[bj][n] = bias ? *(const f32x4*)(bias + bcol0 + bj * 128 + 4 * n) : (f32x4){0.f, 0.f, 0.f, 0.f};
#pragma unroll
        for (int ai = 0; ai < 2; ++ai)
#pragma unroll
            for (int m = 0; m < 4; ++m) {
                const size_t eoff = esplit + (size_t)(row0 + ai * 128 + m * 16) * ldc + col0;
#pragma unroll
                for (int bj = 0; bj < 2; ++bj) {
                    f32x4 v0 = acc[ai][bj][m][0] + bv[bj][0], v1 = acc[ai][bj][m][1] + bv[bj][1];
                    if (mode == 1) {
#pragma unroll
                        for (int j = 0; j < 4; ++j) { v0[j] = 1.f - 2.f * __builtin_amdgcn_rcpf(1.f + __expf(2.f * v0[j])); v1[j] = 1.f - 2.f * __builtin_amdgcn_rcpf(1.f + __expf(2.f * v1[j])); }
                    } else if (mode == 2 || mode == 3) {
#pragma unroll
                        for (int j = 0; j < 4; ++j) { v0[j] = sigmoidf_(v0[j]); v1[j] = sigmoidf_(v1[j]); }
                    } else if (mode == 4) {
#pragma unroll
                        for (int j = 0; j < 4; ++j) { v0[j] = __expf(-0.6065306597f * sigmoidf_(v0[j])); v1[j] = __expf(-0.6065306597f * sigmoidf_(v1[j])); }
                    }
                    if (mode == 4) {
                        typedef _Float16 h2 __attribute__((ext_vector_type(2)));
                        pg8::u32x4 w;
                        w.x = __builtin_bit_cast(unsigned, (h2){(_Float16)(1.f - v0[0]), (_Float16)(1.f - v0[1])}); w.y = __builtin_bit_cast(unsigned, (h2){(_Float16)(1.f - v0[2]), (_Float16)(1.f - v0[3])});
                        w.z = __builtin_bit_cast(unsigned, (h2){(_Float16)(1.f - v1[0]), (_Float16)(1.f - v1[1])}); w.w = __builtin_bit_cast(unsigned, (h2){(_Float16)(1.f - v1[2]), (_Float16)(1.f - v1[3])});
                        *(pg8::u32x4*)((bf16*)base + eoff + bj * 128) = w;
                    } else {
                        pg8::u32x4 w; w.x = cvt_pk_bf16(v0[0], v0[1]); w.y = cvt_pk_bf16(v0[2], v0[3]); w.z = cvt_pk_bf16(v1[0], v1[1]); w.w = cvt_pk_bf16(v1[2], v1[3]);
                        *(pg8::u32x4*)((bf16*)base + eoff + bj * 128) = w;
                    }
                }
            }
    }
};
struct EpiRes {
    static constexpr bool PERM = true; static constexpr int MIN_VM = 16;
    bf16* X; const float* gate3; float* outp; float* part; const float* xin;
    __device__ __forceinline__ void operator()(const f32x4 (&acc)[2][2][4][2], const pg8::Unit& u, int wr, int wc, int fr, int fq) const {
        const int b = u.lm / 17, tb = u.lm - b * 17; const int isctx = (tb == 16);
        const float* gate = gate3 + (size_t)(isctx ? 2 : b) * (6 * D);
        const int row0 = u.lm * 256 + wr * 64 + fr, col0 = u.ln * 256 + wc * 32 + 8 * fq;
        if (u.kpart >= 0) {
            float* pb = part + ((size_t)u.kpart * 512 + (size_t)b * 256 + wr * 64 + fr) * D + col0;
#pragma unroll
            for (int ai = 0; ai < 2; ++ai)
#pragma unroll
                for (int m = 0; m < 4; ++m)
#pragma unroll
                    for (int bj = 0; bj < 2; ++bj) { float* p = pb + (size_t)(ai * 128 + m * 16) * D + bj * 128; *(f32x4*)p = acc[ai][bj][m][0]; *(f32x4*)(p + 4) = acc[ai][bj][m][1]; }
            return;
        }
        if (outp && isctx) { asm volatile("s_waitcnt vmcnt(0)" ::: "memory"); return; }
        const long radj = (long)(b * 16 + tb) * 256 - (long)u.lm * 256;
        f32x4 gv[2][2];
#pragma unroll
        for (int bj = 0; bj < 2; ++bj)
#pragma unroll
            for (int n = 0; n < 2; ++n) gv[bj][n] = *(const f32x4*)(gate + col0 + bj * 128 + 4 * n);
#pragma unroll
        for (int ai = 0; ai < 2; ++ai)
#pragma unroll
            for (int m = 0; m < 4; ++m) {
                const int row = row0 + ai * 128 + m * 16;
                bf16* xb = X + (size_t)row * D + col0;
#pragma unroll
                for (int bj = 0; bj < 2; ++bj) {
                    f32x4 x0, x1;
                    if (xin) { const float* xp = xin + (size_t)(row + radj) * D + col0 + bj * 128; x0 = *(const f32x4*)xp; x1 = *(const f32x4*)(xp + 4); }
                    else { const pg8::u32x4 t = *(const pg8::u32x4*)(xb + bj * 128); x0 = (f32x4){bflo(t.x), bfhi(t.x), bflo(t.y), bfhi(t.y)}; x1 = (f32x4){bflo(t.z), bfhi(t.z), bflo(t.w), bfhi(t.w)}; }
                    const f32x4 y0 = x0 + gv[bj][0] * acc[ai][bj][m][0], y1 = x1 + gv[bj][1] * acc[ai][bj][m][1];
                    if (outp) { float* op = outp + (size_t)(row + radj) * D + col0 + bj * 128; *(f32x4*)op = y0; *(f32x4*)(op + 4) = y1; }
                    else { pg8::u32x4 w; w.x = cvt_pk_bf16(y0.x, y0.y); w.y = cvt_pk_bf16(y0.z, y0.w); w.z = cvt_pk_bf16(y1.x, y1.y); w.w = cvt_pk_bf16(y1.z, y1.w); *(pg8::u32x4*)(xb + bj * 128) = w; }
                }
            }
    }
};


struct EpiQKV {
    static constexpr bool PERM = true; static constexpr int MIN_VM = 16;
    bf16* O; int ldc, nqk, nq; const float* qg; const float* kg; int rope; LAS float* part;
    __device__ __forceinline__ void operator()(const f32x4 (&acc)[2][2][4][2], const pg8::Unit& u, int wr, int wc, int fr_in, int fq_in) const {
        int fr = fr_in, fq = fq_in; asm volatile("" : "+v"(fr), "+v"(fq));
        const bool isqk = u.ln < nqk;
        if (isqk) {
#pragma unroll
            for (int ai = 0; ai < 2; ++ai)
#pragma unroll
                for (int m = 0; m < 4; ++m)
#pragma unroll
                    for (int bj = 0; bj < 2; ++bj) {
                        const f32x4 a = acc[ai][bj][m][0], b = acc[ai][bj][m][1];
                        float s = ((a.x * a.x + a.y * a.y) + (a.z * a.z + a.w * a.w)) + ((b.x * b.x + b.y * b.y) + (b.z * b.z + b.w * b.w));
                        { const auto x = __builtin_amdgcn_permlane16_swap(__float_as_uint(s), __float_as_uint(s), false, false); s = __uint_as_float(x[0]) + __uint_as_float(x[1]); }
                        { const auto x = __builtin_amdgcn_permlane32_swap(__float_as_uint(s), __float_as_uint(s), false, false); s = __uint_as_float(x[0]) + __uint_as_float(x[1]); }
                        if (fq == 0) part[((ai * 128 + wr * 64 + m * 16 + fr) * 2 + bj) * 4 + wc] = s;
                    }
        }
        asm volatile("s_waitcnt lgkmcnt(0)" ::: "memory"); __builtin_amdgcn_s_barrier(); asm volatile("" ::: "memory");
        const float* g = (u.ln < nq) ? qg : kg;
        const int cc0 = 32 * (wc & 1) + 8 * fq;
        const float* gA = rope ? (g + 64 * (wc >> 1) + (cc0 >> 1)) : (g + 32 * wc + 8 * fq);
        const float* gB = rope ? (gA + 32) : (gA + 4);
#pragma unroll
        for (int ai = 0; ai < 2; ++ai)
#pragma unroll
            for (int m = 0; m < 4; ++m) {
                const int rl = ai * 128 + wr * 64 + m * 16 + fr, row = u.lm * 256 + rl;
                const int tb = row % SB; const bool lat = tb < SEQ;
                const float ps = (float)((wc >> 1) ? (tb & 63) : (tb >> 6));
#pragma unroll
                for (int bj = 0; bj < 2; ++bj) {
                    float x[8]; { const f32x4 t0 = acc[ai][bj][m][0], t1 = acc[ai][bj][m][1]; x[0] = t0.x; x[1] = t0.y; x[2] = t0.z; x[3] = t0.w; x[4] = t1.x; x[5] = t1.y; x[6] = t1.z; x[7] = t1.w; }
                    if (isqk) {
                        const f32x4 p4 = *(const LAS f32x4*)(part + (rl * 2 + bj) * 4);
                        const float rstd = rsqrtf(((p4.x + p4.y) + (p4.z + p4.w)) * (1.f / 128.f) + NORM_EPS);
                        const f32x4 ga = *(const f32x4*)gA, gb = *(const f32x4*)gB;
                        if (rope) { x[0] *= rstd * ga.x; x[1] *= rstd * gb.x; x[2] *= rstd * ga.y; x[3] *= rstd * gb.y; x[4] *= rstd * ga.z; x[5] *= rstd * gb.z; x[6] *= rstd * ga.w; x[7] *= rstd * gb.w; }
                        else { x[0] *= rstd * ga.x; x[1] *= rstd * ga.y; x[2] *= rstd * ga.z; x[3] *= rstd * ga.w; x[4] *= rstd * gb.x; x[5] *= rstd * gb.y; x[6] *= rstd * gb.z; x[7] *= rstd * gb.w; }
                        if (rope && lat) {
#pragma unroll
                            for (int pq = 0; pq < 4; ++pq) { const float ang = ps * __builtin_amdgcn_exp2f(-(float)((cc0 >> 1) + pq) * (13.287712379549449f / 32.f)), cs = __cosf(ang), sn = __sinf(ang), x1 = x[2 * pq], x2 = x[2 * pq + 1];
                                x[2 * pq] = x1 * cs - x2 * sn; x[2 * pq + 1] = x1 * sn + x2 * cs; }
                        }
                    }
                    pg8::u32x4 w; w.x = cvt_pk_bf16_v(x[0], x[1]); w.y = cvt_pk_bf16_v(x[2], x[3]); w.z = cvt_pk_bf16_v(x[4], x[5]); w.w = cvt_pk_bf16_v(x[6], x[7]);
                    *(pg8::u32x4*)(O + (size_t)row * ldc + u.ln * 256 + bj * 128 + wc * 32 + 8 * fq) = w;
                }
                asm volatile("" ::: "memory");
            }
    }
};

template <int CTRL, bool BC> __device__ __forceinline__ float dppu(float old, float v) { return __builtin_bit_cast(float, __builtin_amdgcn_update_dpp(__builtin_bit_cast(int, old), __builtin_bit_cast(int, v), CTRL, 0xF, 0xF, BC)); }
struct EpiUp {
    static constexpr bool PERM = true; static constexpr int MIN_VM = 8;
    bf16* ACT; float* HALO; const float* cw; const float* cb;
    __device__ __forceinline__ void operator()(const f32x4 (&acc)[2][2][4][2], const pg8::Unit& u, int wr, int wc, int fr, int fq) const {
        const int f0 = u.ln * 128 + wc * 32 + 8 * fq;
#pragma unroll
        for (int ai = 0; ai < 2; ++ai) {
            const int rowbase = u.lm * 256 + ai * 128 + wr * 64, grp = rowbase >> 6;
            if (fr < 2 || fr >= 14) {
                const int m = fr < 2 ? 0 : 3; float* hp = HALO + (size_t)(grp * 4 + (fr < 2 ? fr : fr - 12)) * DFF2 + f0;
#pragma unroll
                for (int bj = 0; bj < 2; ++bj)
#pragma unroll
                    for (int n = 0; n < 2; ++n) *(f32x4*)(hp + bj * DFF + 4 * n) = fr < 2 ? acc[ai][bj][0][n] : acc[ai][bj][3][n];
                (void)m;
            }
            unsigned ow[4][4];
#pragma unroll
            for (int n = 0; n < 2; ++n) {
                const int fc = f0 + 4 * n;
                const f32x4 g0 = *(const f32x4*)(cw + fc), g1 = *(const f32x4*)(cw + DFF2 + fc), g2 = *(const f32x4*)(cw + 2 * DFF2 + fc), gb = *(const f32x4*)(cb + fc);
                const f32x4 v0 = *(const f32x4*)(cw + DFF + fc), v1 = *(const f32x4*)(cw + DFF2 + DFF + fc), v2 = *(const f32x4*)(cw + 2 * DFF2 + DFF + fc), vb = *(const f32x4*)(cb + DFF + fc);
                float o[4][4];
#pragma unroll
                for (int e = 0; e < 4; ++e) {
                    float G[4], V[4];
#pragma unroll
                    for (int m = 0; m < 4; ++m) {
                        {   const float c = acc[ai][0][m][n][e];
                            const float pv = (m > 0) ? dppu<0x111, false>(dppu<0x121, true>(0.f, acc[ai][0][m > 0 ? m - 1 : 0][n][e]), c) : dppu<0x111, true>(0.f, c);
                            const float nx = (m < 3) ? dppu<0x101, false>(dppu<0x12F, true>(0.f, acc[ai][0][m < 3 ? m + 1 : 3][n][e]), c) : dppu<0x101, true>(0.f, c);
                            G[m] = gb[e] + g0[e] * pv + g1[e] * c + g2[e] * nx; }
                        {   const float c = acc[ai][1][m][n][e];
                            const float pv = (m > 0) ? dppu<0x111, false>(dppu<0x121, true>(0.f, acc[ai][1][m > 0 ? m - 1 : 0][n][e]), c) : dppu<0x111, true>(0.f, c);
                            const float nx = (m < 3) ? dppu<0x101, false>(dppu<0x12F, true>(0.f, acc[ai][1][m < 3 ? m + 1 : 3][n][e]), c) : dppu<0x101, true>(0.f, c);
                            V[m] = vb[e] + v0[e] * pv + v1[e] * c + v2[e] * nx; }
                        o[m][e] = G[m] * V[m] * __builtin_amdgcn_rcpf(1.f + __expf(-G[m]));
                    }
                }
#pragma unroll
                for (int m = 0; m < 4; ++m) { ow[m][2 * n] = cvt_pk_bf16(o[m][0], o[m][1]); ow[m][2 * n + 1] = cvt_pk_bf16(o[m][2], o[m][3]); }
            }
#pragma unroll
            for (int m = 0; m < 4; ++m) { v4u w; w.x = ow[m][0]; w.y = ow[m][1]; w.z = ow[m][2]; w.w = ow[m][3];
                *(v4u*)(ACT + (size_t)(rowbase + 16 * m + fr) * DFF + f0) = w; }
        }
    }
};

namespace att {
using s16x4  = __attribute__((ext_vector_type(4))) short;
using f32x16 = __attribute__((ext_vector_type(16))) float;
using u32x4  = __attribute__((ext_vector_type(4))) unsigned;
constexpr int KVBLK = 64, QBLK = 32, NW = 8;
constexpr float SCALE = 0.088388347648318440f;
constexpr float THR = 8.f;
constexpr float NEGBIG = -1e30f;
constexpr size_t SHM_V = KVBLK * HD * 2, SHM_K = KVBLK * HD * 2, SHM_ATTN = 2 * SHM_V + 2 * SHM_K + NW * 64 * 4;
#define KSWZ(row, colB) ((row) * 256 + ((colB) ^ (((row) & 7) << 4)))
#define SBAR() __builtin_amdgcn_sched_barrier(0)
__device__ __forceinline__ int crow(int r, int hi) { return (r & 3) + 8 * (r >> 2) + 4 * hi; }
__device__ __forceinline__ unsigned cvtpk(float lo, float hi) { unsigned r; asm volatile("v_cvt_pk_bf16_f32 %0, %1, %2" : "=v"(r) : "v"(lo), "v"(hi)); return r; }

template <bool FIXM = false>
__device__ __forceinline__ void partialSM(f32x16& p0, f32x16& p1, float& m_reg, float& mn, float& alpha) {
  constexpr float C = SCALE * 1.4426950408889634f;
  if constexpr (FIXM) { mn = m_reg; alpha = 1.f; return; }
  float pmax = p0[0]; for (int r = 1; r < 16; ++r) pmax = fmaxf(pmax, p0[r]); for (int r = 0; r < 16; ++r) pmax = fmaxf(pmax, p1[r]);
  { auto rr = __builtin_amdgcn_permlane32_swap(__float_as_uint(pmax), __float_as_uint(pmax), false, false);
    pmax = fmaxf(__uint_as_float(rr[0]), __uint_as_float(rr[1])); }
  if (__builtin_expect(__all(pmax - m_reg <= THR / SCALE), 1)) { mn = m_reg; alpha = 1.f; }
  else { mn = fmaxf(m_reg, pmax); alpha = __builtin_amdgcn_exp2f((m_reg - mn) * C); m_reg = mn; }
  float mnC = -mn * C;
  for (int r = 0; r < 16; ++r) p0[r] = fmaf(p0[r], C, mnC); for (int r = 0; r < 16; ++r) p1[r] = fmaf(p1[r], C, mnC);
  for (int r = 0; r < 16; ++r) p0[r] = __builtin_amdgcn_exp2f(p0[r]);
}
template <bool FIXM = false>
__device__ __forceinline__ void finishSM(f32x16& p0, f32x16& p1, float alpha, float& l_reg, bf16x8& pa0, bf16x8& pa1, bf16x8& pa2, bf16x8& pa3, float mfix = 0.f) {
  if constexpr (FIXM) { constexpr float C = SCALE * 1.4426950408889634f; const float mnC_ = -mfix * C;
    for (int r = 0; r < 16; ++r) p0[r] = __builtin_amdgcn_exp2f(fmaf(p0[r], C, mnC_)); for (int r = 0; r < 16; ++r) p1[r] = __builtin_amdgcn_exp2f(fmaf(p1[r], C, mnC_)); }
  else for (int r = 0; r < 16; ++r) p1[r] = __builtin_amdgcn_exp2f(p1[r]);
  float ps = 0; for (int r = 0; r < 16; ++r) ps += p0[r]; for (int r = 0; r < 16; ++r) ps += p1[r];
  { auto rr = __builtin_amdgcn_permlane32_swap(__float_as_uint(ps), __float_as_uint(ps), false, false);
    ps = __uint_as_float(rr[0]) + __uint_as_float(rr[1]); }
  l_reg = l_reg * alpha + ps;
#define PK4(P, BASE, OUT) do { unsigned a0 = cvtpk(P[BASE + 0], P[BASE + 1]), a1 = cvtpk(P[BASE + 2], P[BASE + 3]);   \
    unsigned b0 = cvtpk(P[BASE + 4], P[BASE + 5]), b1 = cvtpk(P[BASE + 6], P[BASE + 7]);                              \
    auto r0 = __builtin_amdgcn_permlane32_swap(a0, b0, false, false); auto r1 = __builtin_amdgcn_permlane32_swap(a1, b1, false, false); \
    u32x4 w = {r0[0], r1[0], r0[1], r1[1]}; OUT = *reinterpret_cast<bf16x8*>(&w); } while (0)
  PK4(p0, 0, pa0); PK4(p0, 8, pa1); PK4(p1, 0, pa2); PK4(p1, 8, pa3);
#undef PK4
}
template <unsigned M0, unsigned M1>
__device__ __forceinline__ void partialSM_m(f32x16& p0, f32x16& p1, float& m_reg, float& mn, float& alpha) {
  constexpr float C = SCALE * 1.4426950408889634f;
  float pmax = NEGBIG;
#pragma unroll
  for (int r = 0; r < 16; ++r) { pmax = fmaxf(pmax, ((M0 >> r) & 1u) ? p0[r] : NEGBIG); pmax = fmaxf(pmax, ((M1 >> r) & 1u) ? p1[r] : NEGBIG); }
  { auto rr = __builtin_amdgcn_permlane32_swap(__float_as_uint(pmax), __float_as_uint(pmax), false, false);
    pmax = fmaxf(__uint_as_float(rr[0]), __uint_as_float(rr[1])); }
  if (__builtin_expect(__all(pmax - m_reg <= THR / SCALE), 1)) { mn = m_reg; alpha = 1.f; }
  else { mn = fmaxf(m_reg, pmax); alpha = __builtin_amdgcn_exp2f((m_reg - mn) * C); m_reg = mn; }
  const float mnC = -mn * C;
#pragma unroll
  for (int r = 0; r < 16; ++r) { p0[r] = ((M0 >> r) & 1u) ? __builtin_amdgcn_exp2f(fmaf(p0[r], C, mnC)) : 0.f; p1[r] = ((M1 >> r) & 1u) ? fmaf(p1[r], C, mnC) : 0.f; }
}
template <unsigned M0, unsigned M1>
__device__ __forceinline__ void finishSM_m(f32x16& p0, f32x16& p1, float alpha, float& l_reg, bf16x8& pa0, bf16x8& pa1, bf16x8& pa2, bf16x8& pa3) {
  float ps = 0;
#pragma unroll
  for (int r = 0; r < 16; ++r) { p1[r] = ((M1 >> r) & 1u) ? __builtin_amdgcn_exp2f(p1[r]) : 0.f; ps += p1[r]; ps += p0[r]; }
  { auto rr = __builtin_amdgcn_permlane32_swap(__float_as_uint(ps), __float_as_uint(ps), false, false);
    ps = __uint_as_float(rr[0]) + __uint_as_float(rr[1]); }
  l_reg = l_reg * alpha + ps;
#define PK4(P, BASE, OUT) do { unsigned a0 = cvtpk(P[BASE + 0], P[BASE + 1]), a1 = cvtpk(P[BASE + 2], P[BASE + 3]);   \
    unsigned b0 = cvtpk(P[BASE + 4], P[BASE + 5]), b1 = cvtpk(P[BASE + 6], P[BASE + 7]);                              \
    auto r0 = __builtin_amdgcn_permlane32_swap(a0, b0, false, false); auto r1 = __builtin_amdgcn_permlane32_swap(a1, b1, false, false); \
    u32x4 w = {r0[0], r1[0], r0[1], r1[1]}; OUT = *reinterpret_cast<bf16x8*>(&w); } while (0)
  PK4(p0, 0, pa0); PK4(p0, 8, pa1); PK4(p1, 0, pa2); PK4(p1, 8, pa3);
#undef PK4
}
__device__ __forceinline__ void qkt(f32x16& p0, f32x16& p1, const bf16* Ks, const bf16x8* qr, int r32, int hi) {
  p0 = f32x16{}; p1 = f32x16{};
  for (int d0 = 0; d0 < 8; ++d0) { int cb = (d0 * 16 + hi * 8) * 2;
    bf16x8 b0 = *reinterpret_cast<const bf16x8*>((const char*)Ks + KSWZ(r32, cb));
    bf16x8 b1 = *reinterpret_cast<const bf16x8*>((const char*)Ks + KSWZ(32 + r32, cb));
    p0 = __builtin_amdgcn_mfma_f32_32x32x16_bf16(b0, qr[d0], p0, 0, 0, 0);
    p1 = __builtin_amdgcn_mfma_f32_32x32x16_bf16(b1, qr[d0], p1, 0, 0, 0); }
}
__device__ __forceinline__ int v_st(int k, int c) { const int kk = (k & ~0xC) | ((k & 4) << 1) | ((k & 8) >> 1); return ((kk >> 3) * 4 + (c >> 5)) * 512 + ((kk & 7) * 32 + (c & 31)) * 2; }
__device__ __forceinline__ int v_rd_base(int lane) { return ((lane & 3) << 3) | (((lane >> 2) & 3) << 6) | (((lane >> 4) & 1) << 5) | (((lane >> 5) & 1) << 8); }
constexpr int v_rd_off(int d0, int ks, int half) { return d0 * 512 + ks * 4096 + half * 2048; }
template <int OFF> __device__ __forceinline__ s16x4 tr_read(int vb) {
  s16x4 r; asm volatile("ds_read_b64_tr_b16 %0, %1 offset:%2" : "=&v"(r) : "v"(vb), "i"(OFF) : "memory"); return r;
}
template <int D0, int SKIP = 0> __device__ __forceinline__ void pv_one(f32x16& od, int vb, bf16x8 pa0, bf16x8 pa1, bf16x8 pa2, bf16x8 pa3) {
  s16x4 l0 = {}, h0 = {}, l3 = {}, h3 = {};
  if (SKIP != 2) { l0 = tr_read<v_rd_off(D0, 0, 0)>(vb); h0 = tr_read<v_rd_off(D0, 0, 1)>(vb); }
  const s16x4 l1 = tr_read<v_rd_off(D0, 1, 0)>(vb), h1 = tr_read<v_rd_off(D0, 1, 1)>(vb);
  const s16x4 l2 = tr_read<v_rd_off(D0, 2, 0)>(vb), h2 = tr_read<v_rd_off(D0, 2, 1)>(vb);
  if (SKIP != 1) { l3 = tr_read<v_rd_off(D0, 3, 0)>(vb); h3 = tr_read<v_rd_off(D0, 3, 1)>(vb); }
  asm volatile("s_waitcnt lgkmcnt(0)" ::: "memory"); SBAR();
#define PK(L, H) (bf16x8){L[0], L[1], L[2], L[3], H[0], H[1], H[2], H[3]}
  if (SKIP != 2) od = __builtin_amdgcn_mfma_f32_32x32x16_bf16(pa0, PK(l0, h0), od, 0, 0, 0);
  od = __builtin_amdgcn_mfma_f32_32x32x16_bf16(pa1, PK(l1, h1), od, 0, 0, 0);
  od = __builtin_amdgcn_mfma_f32_32x32x16_bf16(pa2, PK(l2, h2), od, 0, 0, 0);
  if (SKIP != 1) od = __builtin_amdgcn_mfma_f32_32x32x16_bf16(pa3, PK(l3, h3), od, 0, 0, 0);
#undef PK
}
template <int SKIP = 0>
__device__ __forceinline__ void pv_d0(f32x16* o, int vb, bf16x8 pa0, bf16x8 pa1, bf16x8 pa2, bf16x8 pa3) {
  pv_one<0, SKIP>(o[0], vb, pa0, pa1, pa2, pa3); pv_one<1, SKIP>(o[1], vb, pa0, pa1, pa2, pa3); pv_one<2, SKIP>(o[2], vb, pa0, pa1, pa2, pa3); pv_one<3, SKIP>(o[3], vb, pa0, pa1, pa2, pa3);
}
struct NaInfo { int r0, rs_lo; const float* tab; float mfix; };
template <unsigned M0 = 0xFFFFu, unsigned M1 = 0xFFFFu>
__device__ __forceinline__ void na_mask(f32x16& p0, f32x16& p1, int j, const NaInfo& na, int wid, int r32, int hi) {
  if (j < 4) return;
  const int rq = na.r0 + (wid >> 1); int rsq = rq - 4; rsq = rsq < 0 ? 0 : (rsq > 56 ? 56 : rsq);
  const int kr = na.rs_lo + (j - 4);
  const bool valid = (kr >= rsq) && (kr < rsq + 8);
  if (!valid) {
#pragma unroll
    for (int r = 0; r < 16; ++r) { p0[r] = NEGBIG; p1[r] = NEGBIG; }
    return;
  }
  const int dr = kr - rq + 7;
  const int c = (wid & 1) * 32 + r32; int cs = c - 8; cs = cs < 0 ? 0 : (cs > 48 ? 48 : cs);
  const float* tb = na.tab + 64 + dr * 31 - c + 15 + 4 * hi;
  const int t0 = 4 * hi - cs;
#pragma unroll
  for (int r = 0; r < 16; ++r) {
    const int o = (r & 3) + 8 * (r >> 2);
    { const bool in = (unsigned)(t0 + o) < 16u; const float bsv = tb[o]; p0[r] = ((M0 >> r) & 1u) ? (in ? p0[r] + bsv : NEGBIG) : NEGBIG; }
    { const bool in = (unsigned)(t0 + o + 32) < 16u; const float bsv = tb[o + 32]; p1[r] = ((M1 >> r) & 1u) ? (in ? p1[r] + bsv : NEGBIG) : NEGBIG; }
  }
}
template <int LDQ, int LDK, int LDO, bool NA, bool FIXM = false>
__device__ __forceinline__ void attn_unit(const bf16* __restrict__ Qb, const bf16* __restrict__ Kh, const bf16* __restrict__ Vh, bf16* __restrict__ Ob,
                                          int NT, int nfirst, int first0, int second0, char* lds, const NaInfo na) {
  const int tid = ltid(), wid = tid >> 6, lane = tid & 63, r32 = lane & 31, hi = lane >> 5;
  bf16* V_lds = (bf16*)lds; bf16* K_lds = (bf16*)(lds + 2 * SHM_V);
  float* ws = (float*)(lds + 2 * SHM_V + 2 * SHM_K) + wid * 64; float* li_l = ws; float* al_l = ws + 32;
  float m_reg = FIXM ? na.mfix : -1e30f, l_reg = 0; f32x16 o[4] = {}; bf16x8 qr[8];
  const bf16* Qw = Qb + (long)(wid * QBLK + r32) * LDQ + hi * 8;
#pragma unroll
  for (int d0 = 0; d0 < 8; ++d0) qr[d0] = *reinterpret_cast<const bf16x8*>(Qw + d0 * 16);
  const int sr = tid >> 4, sc = (tid & 15) * 8, vst0 = v_st(sr, sc), vst1 = v_st(32 + sr, sc);
  const int vb0 = (int)(uintptr_t)V_lds + v_rd_base(lane);
  struct { bf16x8 vs0, vs1, ks0, ks1; } sr_[2];
#define KROW(j) ((j) < nfirst ? first0 + 64 * (j) : second0 + 64 * ((j) - nfirst))
#define SLOAD(i, jt) do { const long k0_ = KROW(jt); sr_[i].vs0 = *reinterpret_cast<const bf16x8*>(&Vh[(k0_ + sr) * LDK + sc]); sr_[i].vs1 = *reinterpret_cast<const bf16x8*>(&Vh[(k0_ + 32 + sr) * LDK + sc]); \
    sr_[i].ks0 = *reinterpret_cast<const bf16x8*>(&Kh[(k0_ + sr) * LDK + sc]); sr_[i].ks1 = *reinterpret_cast<const bf16x8*>(&Kh[(k0_ + 32 + sr) * LDK + sc]); } while (0)
#define SWRITE(b, i) do { *(bf16x8*)((char*)V_lds + (b) * SHM_V + vst0) = sr_[i].vs0;          \
    *(bf16x8*)((char*)V_lds + (b) * SHM_V + vst1) = sr_[i].vs1; int kc = sc * 2;               \
    *(bf16x8*)((char*)K_lds + (b) * SHM_K + KSWZ(sr, kc)) = sr_[i].ks0;                       \
    *(bf16x8*)((char*)K_lds + (b) * SHM_K + KSWZ(32 + sr, kc)) = sr_[i].ks1; } while (0)
#define SWAIT() asm volatile("s_waitcnt vmcnt(4)" ::: "memory")
#define RESC(a) do { if (!FIXM && __any((a) < 1.f)) { if (hi == 0) al_l[r32] = (a); asm volatile("s_waitcnt lgkmcnt(0)" ::: "memory"); \
    for (int d = 0; d < 4; ++d) for (int r = 0; r < 16; ++r) o[d][r] *= al_l[crow(r, hi)]; } } while (0)
  f32x16 pA0, pA1, pB0, pB1; float mnA, mnB, alA, alB; bf16x8 pa0, pa1, pa2, pa3;
  constexpr int SE = 0, SO = 1;
  SLOAD(SE, 0); asm volatile("s_waitcnt vmcnt(0)" ::: "memory"); SWRITE(0, SE); __syncthreads();
  qkt(pA0, pA1, K_lds, qr, r32, hi); if (NA) na_mask(pA0, pA1, 0, na, wid, r32, hi); partialSM<FIXM>(pA0, pA1, m_reg, mnA, alA);
  SLOAD(SO, 1); if (2 < NT) SLOAD(SE, 2);
  SWAIT(); SWRITE(1, SO); __syncthreads();
  for (int j = 1; j + 1 < NT; j += 2) {
    SBAR(); qkt(pB0, pB1, (bf16*)((char*)K_lds + SHM_K), qr, r32, hi); if (NA) na_mask(pB0, pB1, j, na, wid, r32, hi);
    finishSM<FIXM>(pA0, pA1, alA, l_reg, pa0, pa1, pa2, pa3, na.mfix); SBAR();
    SLOAD(SO, (j + 2)); SBAR();
    pv_d0(o, vb0, pa0, pa1, pa2, pa3); partialSM<FIXM>(pB0, pB1, m_reg, mnB, alB);
    __syncthreads(); SWAIT(); SWRITE(0, SE);
    RESC(alB); __syncthreads();
    SBAR(); qkt(pA0, pA1, K_lds, qr, r32, hi); if (NA) na_mask(pA0, pA1, j + 1, na, wid, r32, hi);
    finishSM<FIXM>(pB0, pB1, alB, l_reg, pa0, pa1, pa2, pa3, na.mfix); SBAR();
    if (j + 3 < NT) SLOAD(SE, (j + 3)); SBAR();
    pv_d0(o, vb0 + (int)SHM_V, pa0, pa1, pa2, pa3); partialSM<FIXM>(pA0, pA1, m_reg, mnA, alA);
    __syncthreads(); SWAIT(); SWRITE(1, SO);
    RESC(alA); __syncthreads();
  }
  SBAR(); qkt(pB0, pB1, (bf16*)((char*)K_lds + SHM_K), qr, r32, hi); if (NA) na_mask(pB0, pB1, NT - 1, na, wid, r32, hi);
  finishSM<FIXM>(pA0, pA1, alA, l_reg, pa0, pa1, pa2, pa3, na.mfix); SBAR();
  pv_d0(o, vb0, pa0, pa1, pa2, pa3); partialSM<FIXM>(pB0, pB1, m_reg, mnB, alB);
  __syncthreads(); RESC(alB);
  finishSM<FIXM>(pB0, pB1, alB, l_reg, pa0, pa1, pa2, pa3, na.mfix); SBAR();
  pv_d0(o, vb0 + (int)SHM_V, pa0, pa1, pa2, pa3);
  if (hi == 0) li_l[r32] = l_reg; asm volatile("s_waitcnt lgkmcnt(0)" ::: "memory");
  float rli[16];
#pragma unroll
  for (int r = 0; r < 16; ++r) rli[r] = __builtin_amdgcn_rcpf(li_l[crow(r, hi)]);
  bf16* Ow = Ob + (long)(wid * QBLK) * LDO;
#pragma unroll
  for (int r = 0; r < 16; ++r) { int orow = crow(r, hi);
#pragma unroll
    for (int d0 = 0; d0 < 4; ++d0) Ow[(long)orow * LDO + d0 * 32 + r32] = (bf16)(cvtpk(o[d0][r] * rli[r], 0.f) & 0xffffu); }
  __syncthreads();
#undef KROW
#undef SLOAD
#undef SWRITE
#undef SWAIT
#undef RESC
}

template <int LDQ, int LDK, int LDO, bool NA>
__device__ __forceinline__ void attn_unit_simple(const bf16* __restrict__ Qb, const bf16* __restrict__ Kh, const bf16* __restrict__ Vh, bf16* __restrict__ Ob,
                                                 int NT, int nfirst, int first0, int second0, char* lds, const NaInfo na) {
  const int tid = ltid(), wid = tid >> 6, lane = tid & 63, r32 = lane & 31, hi = lane >> 5;
  bf16* V_lds = (bf16*)lds; bf16* K_lds = (bf16*)(lds + 2 * SHM_V);
  float* ws = (float*)(lds + 2 * SHM_V + 2 * SHM_K) + wid * 64; float* li_l = ws; float* al_l = ws + 32;
  float m_reg = -1e30f, l_reg = 0; f32x16 o[4] = {}; bf16x8 qr[8];
  const bf16* Qw = Qb + (long)(wid * QBLK + r32) * LDQ + hi * 8;
#pragma unroll
  for (int d0 = 0; d0 < 8; ++d0) qr[d0] = *reinterpret_cast<const bf16x8*>(Qw + d0 * 16);
  const int sr = tid >> 4, sc = (tid & 15) * 8, vst0 = v_st(sr, sc), vst1 = v_st(32 + sr, sc);
  const int vb0 = (int)(uintptr_t)V_lds + v_rd_base(lane);
  bf16x8 vs0, vs1, ks0, ks1;
#define KROW(j) ((j) < nfirst ? first0 + 64 * (j) : second0 + 64 * ((j) - nfirst))
#define SLOAD1(jt) do { const long k0_ = KROW(jt); vs0 = *reinterpret_cast<const bf16x8*>(&Vh[(k0_ + sr) * LDK + sc]); vs1 = *reinterpret_cast<const bf16x8*>(&Vh[(k0_ + 32 + sr) * LDK + sc]); \
    ks0 = *reinterpret_cast<const bf16x8*>(&Kh[(k0_ + sr) * LDK + sc]); ks1 = *reinterpret_cast<const bf16x8*>(&Kh[(k0_ + 32 + sr) * LDK + sc]); } while (0)
#define SWRITE1(b) do { *(bf16x8*)((char*)V_lds + (b) * SHM_V + vst0) = vs0; *(bf16x8*)((char*)V_lds + (b) * SHM_V + vst1) = vs1; int kc = sc * 2; \
    *(bf16x8*)((char*)K_lds + (b) * SHM_K + KSWZ(sr, kc)) = ks0; *(bf16x8*)((char*)K_lds + (b) * SHM_K + KSWZ(32 + sr, kc)) = ks1; } while (0)
  SLOAD1(0); asm volatile("s_waitcnt vmcnt(0)" ::: "memory"); SWRITE1(0); __syncthreads();
  for (int j = 0; j < NT; ++j) {
    const int bsel = j & 1;
    if (j + 1 < NT) SLOAD1(j + 1);
    bool live = true;
    if (NA && j >= 4) { const int rq = na.r0 + (wid >> 1); int rsq = rq - 4; rsq = rsq < 0 ? 0 : (rsq > 56 ? 56 : rsq); const int kr = na.rs_lo + (j - 4); live = (kr >= rsq) && (kr < rsq + 8); }
    if (live) {
    f32x16 p0, p1; float mn, alpha; bf16x8 pa0, pa1, pa2, pa3;
    SBAR(); qkt(p0, p1, (bf16*)((char*)K_lds + bsel * SHM_K), qr, r32, hi);
    const int nsel = (NA && j >= 4) ? 1 + (wid & 1) : 0;
    if (nsel == 1) { na_mask<0xFFFFu, 0x000Fu>(p0, p1, j, na, wid, r32, hi); partialSM_m<0xFFFFu, 0x000Fu>(p0, p1, m_reg, mn, alpha); }
    else if (nsel == 2) { na_mask<0xF000u, 0xFFFFu>(p0, p1, j, na, wid, r32, hi); partialSM_m<0xF000u, 0xFFFFu>(p0, p1, m_reg, mn, alpha); }
    else partialSM(p0, p1, m_reg, mn, alpha);
    if (__any(alpha < 1.f)) { if (hi == 0) al_l[r32] = alpha; asm volatile("s_waitcnt lgkmcnt(0)" ::: "memory");
#pragma unroll
      for (int d = 0; d < 4; ++d)
#pragma unroll
        for (int r = 0; r < 16; ++r) o[d][r] *= al_l[crow(r, hi)]; }
    if (nsel == 1) finishSM_m<0xFFFFu, 0x000Fu>(p0, p1, alpha, l_reg, pa0, pa1, pa2, pa3);
    else if (nsel == 2) finishSM_m<0xF000u, 0xFFFFu>(p0, p1, alpha, l_reg, pa0, pa1, pa2, pa3);
    else finishSM(p0, p1, alpha, l_reg, pa0, pa1, pa2, pa3);
    SBAR();
    if (nsel == 1) pv_d0<1>(o, vb0 + bsel * (int)SHM_V, pa0, pa1, pa2, pa3);
    else if (nsel == 2) pv_d0<2>(o, vb0 + bsel * (int)SHM_V, pa0, pa1, pa2, pa3);
    else pv_d0<0>(o, vb0 + bsel * (int)SHM_V, pa0, pa1, pa2, pa3);
    }
    if (j + 1 < NT) { asm volatile("s_waitcnt vmcnt(0)" ::: "memory"); SWRITE1(bsel ^ 1); }
    __syncthreads();
  }
  if (hi == 0) li_l[r32] = l_reg; asm volatile("s_waitcnt lgkmcnt(0)" ::: "memory");
  float rli[16];
#pragma unroll
  for (int r = 0; r < 16; ++r) rli[r] = __builtin_amdgcn_rcpf(li_l[crow(r, hi)]);
  bf16* Ow = Ob + (long)(wid * QBLK) * LDO;
#pragma unroll
  for (int r = 0; r < 16; ++r) { int orow = crow(r, hi);
#pragma unroll
    for (int d0 = 0; d0 < 4; ++d0) Ow[(long)orow * LDO + d0 * 32 + r32] = (bf16)(cvtpk(o[d0][r] * rli[r], 0.f) & 0xffffu); }
  __syncthreads();
#undef KROW
#undef SLOAD1
#undef SWRITE1
}
}

constexpr int RING_OFF = 0, RING_BYTES = 131072;
constexpr int LDSCTL_OFF = RING_BYTES, MISC_OFF = LDSCTL_OFF + 320;
constexpr int LDS_BYTES = 147456;
#define RLX_AGENT __ATOMIC_RELAXED, __HIP_MEMORY_SCOPE_AGENT

#define XB_TMO      128
#define XB_XCNT(j)  (256  + 64 * (j))
#define XB_XSUB(j)  (1280 + 64 * (j))
#define XB_XGEN(j)  (2304 + 64 * (j))
#define XB_TOP      3328
#define XB_TOPGEN   3392
#define XCD_BAR_WORDS 3456
#define XB_SPIN_CAP (1u << 18)
__device__ __forceinline__ unsigned xb_ld(unsigned* p)              { return __hip_atomic_load(p, __ATOMIC_RELAXED, __HIP_MEMORY_SCOPE_AGENT); }
__device__ __forceinline__ unsigned xb_add(unsigned* p, unsigned v) { return __hip_atomic_fetch_add(p, v, __ATOMIC_RELAXED, __HIP_MEMORY_SCOPE_AGENT); }
__device__ __forceinline__ unsigned xb_xcc_id() { return (unsigned)__builtin_amdgcn_s_getreg((3 << 11) | 20) & 0xFu; }
#define XB_SPIN(cond, bar) do { unsigned _sp = 0; while (cond) { __builtin_amdgcn_s_sleep(1); \
    if ((++_sp & 255u) == 0u) { if (xb_ld(&(bar)[XB_TMO])) break; if (_sp > XB_SPIN_CAP) { atomicAdd(&(bar)[XB_TMO], 1u); break; } } } } while (0)
struct XcdBarrier { unsigned* bar; unsigned x; volatile LAS unsigned* st; };
__device__ __forceinline__ XcdBarrier xcd_barrier_post(unsigned* bar, volatile LAS unsigned* st) {
    XcdBarrier b; b.bar = bar; b.x = xb_xcc_id(); b.st = st;
    if (threadIdx.x == 0) (void)xb_add(&bar[XB_XCNT(b.x)], 1u);
    return b;
}
__device__ __forceinline__ void xcd_barrier_complete(unsigned* bar, unsigned x, unsigned& nloc, unsigned& nx) {
    const unsigned G = gridDim.x * gridDim.y * gridDim.z;
    unsigned sum, cnt, mine, sp = 0u;
    for (;;) {
        sum = 0u; cnt = 0u; mine = 0u;
#pragma unroll
        for (unsigned j = 0; j < 16; ++j) { const unsigned c = xb_ld(&bar[XB_XCNT(j)]); sum += c; cnt += (c > 0u) ? 1u : 0u; mine = (j == x) ? c : mine; }
        if (sum == G) break;
        __builtin_amdgcn_s_sleep(1);
        if ((++sp & 255u) == 0u) { if (xb_ld(&bar[XB_TMO])) break; if (sp > XB_SPIN_CAP) { atomicAdd(&bar[XB_TMO], 1u); break; } }
    }
    nloc = mine > 0u ? mine : 1u; nx = cnt > 0u ? cnt : 1u;
}
__device__ __forceinline__ void xcd_barrier(const XcdBarrier& b) {
    asm volatile("s_waitcnt vmcnt(0)" ::: "memory");
    __syncthreads();
    if (threadIdx.x == 0) {
        unsigned* bar = b.bar;
        __builtin_amdgcn_s_waitcnt(0);
        unsigned nloc = b.st[0], nx = b.st[1];
        if (nloc == 0u) { xcd_barrier_complete(bar, b.x, nloc, nx); b.st[0] = nloc; b.st[1] = nx; }
        const unsigned old = xb_add(&bar[XB_XSUB(b.x)], 1u);
        const unsigned gen = old / nloc;
        if (old + 1u == (gen + 1u) * nloc) {
            __builtin_amdgcn_fence(__ATOMIC_RELEASE, "agent");
            asm volatile("s_waitcnt vmcnt(0)" ::: "memory");
            const unsigned og = xb_add(&bar[XB_TOP], 1u);
            const unsigned tg = og / nx;
            if (og + 1u == (tg + 1u) * nx) xb_add(&bar[XB_TOPGEN], 1u);
            else XB_SPIN(xb_ld(&bar[XB_TOPGEN]) == tg, bar);
            __builtin_amdgcn_fence(__ATOMIC_ACQUIRE, "agent");
            xb_add(&bar[XB_XGEN(b.x)], 1u);
            asm volatile("s_waitcnt vmcnt(0)" ::: "memory");
        } else {
            XB_SPIN(xb_ld(&bar[XB_XGEN(b.x)]) == gen, bar);
            __builtin_amdgcn_fence(__ATOMIC_ACQUIRE, "agent");
            asm volatile("s_waitcnt vmcnt(0)" ::: "memory");
        }
    }
    __syncthreads();
}
constexpr int CW_BAR = 4096;

struct Frame {
    LAS unsigned char* lds; unsigned char* ldsg;
    int tid, lane, wave, vcu, G, gw, NGW;
    unsigned char* ws; const float* const* in; float* out;
};
__device__ __forceinline__ int row_seqinfo(int row, int& pos, int& len) {
    const int b = row / SB, t = row - b * SB;
    if (t >= SEQ) { pos = t - SEQ; len = CTXL; return 2; }
    pos = t; len = SEQ; return b;
}

__device__ __forceinline__ void transpose_item(const float* W, int ldw, bf16* WT, int ldk, int row_off, LAS float* scr, int kb, int nb, int lane, int rstride = 1) {
    const int k0 = 64 * kb, n0 = 32 * nb;
    float tv[32];
#pragma unroll
    for (int i = 0; i < 32; ++i) tv[i] = __builtin_nontemporal_load(W + (size_t)(k0 + 2 * i + (lane >> 5)) * ldw + n0 + (lane & 31));
#pragma unroll
    for (int i = 0; i < 32; ++i) scr[(2 * i + (lane >> 5)) * 33 + (lane & 31)] = tv[i];
    asm volatile("s_waitcnt lgkmcnt(0)" ::: "memory");
    const int c = lane & 7;
#pragma unroll
    for (int j = 0; j < 4; ++j) { const int n = (lane >> 3) + 8 * j; const LAS float* s = scr + (8 * c) * 33 + n;
        v4u o; o.x = cvt_pk_bf16(s[0 * 33], s[1 * 33]); o.y = cvt_pk_bf16(s[2 * 33], s[3 * 33]); o.z = cvt_pk_bf16(s[4 * 33], s[5 * 33]); o.w = cvt_pk_bf16(s[6 * 33], s[7 * 33]);
        *(v4u*)(WT + (size_t)(row_off + n0 + rstride * n) * ldk + k0 + 8 * c) = o; }
    asm volatile("s_waitcnt lgkmcnt(0)" ::: "memory");
}
struct TJob { int in_idx; unsigned long long in_off; int K, N; unsigned long long dst_off; int row_off; };
#define NTJ 20
__constant__ TJob g_tj[NTJ] = {
    {8, 0ull * 2048 * 11264, 2048, 11264, WS_UPT + 0ull * 11264 * 2048 * 2, -1}, {8, 1ull * 2048 * 11264, 2048, 11264, WS_UPT + 1ull * 11264 * 2048 * 2, -1},
    {8, 2ull * 2048 * 11264, 2048, 11264, WS_UPT + 2ull * 11264 * 2048 * 2, -1}, {8, 3ull * 2048 * 11264, 2048, 11264, WS_UPT + 3ull * 11264 * 2048 * 2, -1},
    {11, 0ull * 5632 * 2048, 5632, 2048, WS_DNT + 0ull * 2048 * 5632 * 2, 0}, {11, 1ull * 5632 * 2048, 5632, 2048, WS_DNT + 1ull * 2048 * 5632 * 2, 0},
    {11, 2ull * 5632 * 2048, 5632, 2048, WS_DNT + 2ull * 2048 * 5632 * 2, 0}, {11, 3ull * 5632 * 2048, 5632, 2048, WS_DNT + 3ull * 2048 * 5632 * 2, 0},
    {13, 0ull * 2048 * 2048, 2048, 2048, WS_RWT, 0}, {13, 1ull * 2048 * 2048, 2048, 2048, WS_RWT, 2048}, {13, 2ull * 2048 * 2048, 2048, 2048, WS_RWT, 4096},
    {13, 3ull * 2048 * 2048, 2048, 2048, WS_RWT + 28ull * 256 * 2048 * 2, 0}, {13, 4ull * 2048 * 2048, 2048, 2048, WS_RWT + 28ull * 256 * 2048 * 2, 2048}, {13, 5ull * 2048 * 2048, 2048, 2048, WS_RWT + 28ull * 256 * 2048 * 2, 4096},
    {27, 0, 2048, 2048, WS_RWOT, 0}, {27, 1ull * 2048 * 2048, 2048, 2048, WS_RWOT + 2048ull * 2048 * 2, 0},
    {31, 0, 2048, 6144, WS_NAQKVT, 0}, {35, 0, 2048, 2048, WS_NAOT, 0}, {36, 0, 2048, 3072, WS_GAQKVT, -2}, {39, 0, 2048, 2048, WS_GAOT, 0},
};
__device__ __forceinline__ void pro_transposes(Frame& F) {
    LAS float* scr = (LAS float*)(F.lds + RING_OFF + F.wave * 16384);
    int base = 0;
    for (int jb = 0; jb < NTJ; ++jb) {
        const int K = g_tj[jb].K, N = g_tj[jb].N, nkb = K / 64, nnb = N / 32, nit = (nkb / 2) * nnb;
        const float* W = F.in[g_tj[jb].in_idx] + g_tj[jb].in_off; bf16* WT = (bf16*)(F.ws + g_tj[jb].dst_off); const int ro = g_tj[jb].row_off;
        int first = (F.gw - base % F.NGW + F.NGW) % F.NGW;
        for (int it = first; it < nit; it += F.NGW) {
            const int nb = it % nnb; int roff = ro;
            if (ro < 0) { const int n0 = 32 * nb, nn = n0 < DFF ? n0 : n0 - DFF; roff = ((nn >> 7) * 256 + (n0 < DFF ? 0 : 128) + (nn & 127)) - n0; }
            int rstr = 1;
            if (ro == -2) { const int n0 = 32 * nb; roff = 0; if (n0 < 2560) { roff = ((n0 >> 6) * 64 + ((n0 >> 5) & 1)) - n0; rstr = 2; } }
            transpose_item(W, N, WT, K, roff, scr, 2 * (it / nnb), nb, F.lane, rstr);
            transpose_item(W, N, WT, K, roff, scr, 2 * (it / nnb) + 1, nb, F.lane, rstr);
        }
        base += nit;
    }
}
__device__ __forceinline__ void pro_small(Frame& F) {
    const size_t gt = (size_t)F.vcu * 512 + F.tid, NT = (size_t)F.G * 512;
    for (int j = 0; j < 2; ++j) {
        bf16* RWT = (bf16*)(F.ws + WS_RWT) + (size_t)j * 28 * 256 * 2048;
        for (size_t i = gt; i < (size_t)1024 * 2048; i += NT) {
            const int rr = (int)(i / 2048), k = (int)(i % 2048), blk = rr >> 8, n = rr & 255; float v = 0.f;
            if (blk == 0) { const int d = n >> 7, q = n & 127; if (q < 96) v = F.in[15][(((size_t)j * 2 + d) * 2048 + k) * 96 + q]; }
            else if (blk == 1) { const int d = n >> 7, q = n & 127; if (q < 96) v = F.in[18][(((size_t)j * 2 + d) * 2048 + k) * 96 + q]; }
            else if (blk == 2) { v = F.in[20][((size_t)j * 2048 + k) * 256 + n]; }
            else { if (j == 1 && n < 64) v = F.in[29][(size_t)k * 64 + n]; }
            RWT[(size_t)(6144 + rr) * 2048 + k] = (bf16)(cvt_pk_bf16(v, 0.f) & 0xffffu);
        }
        bf16* L2T = (bf16*)(F.ws + WS_RL2T) + (size_t)j * 48 * 256 * 256;
        for (size_t i = gt; i < (size_t)12288 * 256; i += NT) {
            const int rr = (int)(i / 256), k = (int)(i % 256); float v = 0.f;
            if (rr < 4096) { const int d = rr / 2048, c = rr % 2048; const int kk = k - d * 128; if (kk >= 0 && kk < 96) v = F.in[16][(((size_t)j * 2 + d) * 96 + kk) * 2048 + c]; }
            else if (rr < 8192) { const int r2 = rr - 4096, d = r2 / 2048, c = r2 % 2048; const int kk = k - d * 128; if (kk >= 0 && kk < 96) v = F.in[19][(((size_t)j * 2 + d) * 96 + kk) * 2048 + c]; }
            else if (rr < 10240) { const int c = rr - 8192; v = F.in[21][((size_t)j * 256 + k) * 2048 + c]; }
            else { const int c = rr - 10240; if (j == 1 && k < 64) v = F.in[30][(size_t)k * 2048 + c]; }
            L2T[i] = (bf16)(cvt_pk_bf16(v, 0.f) & 0xffffu);
        }
    }
}
__device__ __forceinline__ void pro_mod(Frame& F) {
    LAS float* sl = (LAS float*)(F.lds + RING_OFF);
    LAS float* red = (LAS float*)(F.lds + RING_OFF + 32768);
    for (int i = F.tid; i < 3 * 2048; i += 512) { const int s = i / 2048, d = i % 2048; const float c = (s < 2) ? F.in[1][s * 2048 + d] : F.in[3][d]; sl[i] = c * sigmoidf_(c); }
    __syncthreads();
    float* MOD = (float*)(F.ws + WS_MOD);
    for (int it = F.vcu; it < 256; it += F.G) {
        const int l = it >> 6, blk = it & 63, col = 192 * blk + 3 * F.lane;
        const float* W = F.in[4] + (size_t)l * 2048 * 12288 + col;
        float a[3][3];
#pragma unroll
        for (int s = 0; s < 3; ++s) { a[s][0] = 0.f; a[s][1] = 0.f; a[s][2] = 0.f; }
        const int d0 = F.wave * 256;
#pragma unroll 8
        for (int dd = 0; dd < 256; ++dd) {
            const int d = d0 + dd; const float* wp = W + (size_t)d * 12288;
            const float w0 = __builtin_nontemporal_load(wp), w1 = __builtin_nontemporal_load(wp + 1), w2 = __builtin_nontemporal_load(wp + 2);
#pragma unroll
            for (int s = 0; s < 3; ++s) { const float sv = sl[s * 2048 + d]; a[s][0] += sv * w0; a[s][1] += sv * w1; a[s][2] += sv * w2; }
        }
#pragma unroll
        for (int s = 0; s < 3; ++s)
#pragma unroll
            for (int e = 0; e < 3; ++e) red[(F.wave * 9 + s * 3 + e) * 64 + F.lane] = a[s][e];
        __syncthreads();
        for (int idx = F.tid; idx < 576; idx += 512) {
            const int s = idx / 192, cc = idx % 192, ln = cc / 3, e = cc % 3; float v = 0.f;
#pragma unroll
            for (int w = 0; w < 8; ++w) v += red[(w * 9 + s * 3 + e) * 64 + ln];
            const int j = 192 * blk + cc;
            MOD[((size_t)l * 3 + s) * 12288 + j] = v + F.in[5][(size_t)l * 12288 + j];
        }
        __syncthreads();
    }
}

__device__ __forceinline__ void phase_norm(Frame& F, const float* gain, const float* mod3  , bf16* Hout, float* H32, int nparts, const float* pgate  , int lat_only,
                                           const float* xin_lat = nullptr, const float* xin_ctx = nullptr  ) {
    bf16* X = (bf16*)(F.ws + WS_X); const float* PART = (const float*)(F.ws + WS_PART);
    for (int li = F.gw; li < NB * SEQ; li += F.NGW) {
        const int s = li / SEQ, pos = li - s * SEQ, row = s * SB + pos;
        v2u* xr = (v2u*)(X + (size_t)row * D) + F.lane;
        f32x4 v[8]; float ss = 0.f;
        if (xin_lat) { const f32x4* xs = (const f32x4*)(xin_lat + ((size_t)s * SEQ + pos) * D) + F.lane;
#pragma unroll
            for (int j = 0; j < 8; ++j) v[j] = xs[64 * j];
        } else {
#pragma unroll
            for (int j = 0; j < 8; ++j) { const v2u t_ = xr[64 * j]; v[j] = (f32x4){bflo(t_.x), bfhi(t_.x), bflo(t_.y), bfhi(t_.y)}; }
        }
#pragma unroll
        for (int j = 0; j < 8; ++j) ss += (v[j].x * v[j].x + v[j].y * v[j].y) + (v[j].z * v[j].z + v[j].w * v[j].w);
        const float rstd = rsqrtf(wave_sum(ss) * (1.f / D) + NORM_EPS);
        const float* sh = mod3 + (size_t)s * (6 * D); const float* sc = sh + D;
#pragma unroll
        for (int j = 0; j < 8; ++j) {
            const int col = 4 * F.lane + 256 * j;
            const f32x4 g = *(const f32x4*)(gain + col), a = *(const f32x4*)(sc + col), b = *(const f32x4*)(sh + col);
            f32x4 y = v[j] * rstd * g; y = y * (a + 1.0f) + b;
            v2u o; o.x = cvt_pk_bf16(y.x, y.y); o.y = cvt_pk_bf16(y.z, y.w);
            *(v2u*)(Hout + (size_t)row * D + col) = o;
            if (H32) *(f32x4*)(H32 + (size_t)row * D + col) = y;
        }
    }
    if (lat_only) return;
    LAS float* red = (LAS float*)(F.lds + RING_OFF);
    int par = 0;
    for (int ci = F.vcu; ci < NB * CTXL; ci += F.G, par ^= 1) {
        const int bb = ci / CTXL, pos = ci - bb * CTXL, row = bb * SB + SEQ + pos, col = 256 * F.wave + 4 * F.lane;
        v2u* xr = (v2u*)(X + (size_t)row * D + col);
        f32x4 v;
        if (xin_ctx) v = *(const f32x4*)(xin_ctx + ((size_t)bb * CTXL + pos) * D + col);
        else { const v2u t_ = *xr; v = (f32x4){bflo(t_.x), bfhi(t_.x), bflo(t_.y), bfhi(t_.y)}; }
        if (nparts > 0) {
            f32x4 pv[11];
#pragma unroll
            for (int k = 0; k < 11; ++k) pv[k] = (k < nparts) ? *(const f32x4*)(PART + ((size_t)k * 512 + ci) * D + col) : (f32x4){0.f, 0.f, 0.f, 0.f};
            f32x4 a = pv[0];
#pragma unroll
            for (int k = 1; k < 11; ++k) a += pv[k];
            v += a * *(const f32x4*)(pgate + col);
        }
        if (nparts > 0 || xin_ctx) { v2u t_; t_.x = cvt_pk_bf16(v.x, v.y); t_.y = cvt_pk_bf16(v.z, v.w); *xr = t_; }
        const float ssw = wave_sum((v.x * v.x + v.y * v.y) + (v.z * v.z + v.w * v.w));
        if (F.lane == 0) red[par * 8 + F.wave] = ssw;
        __syncthreads();
        float ss = 0.f;
#pragma unroll
        for (int w = 0; w < 8; ++w) ss += red[par * 8 + w];
        const float rstd = rsqrtf(ss * (1.f / D) + NORM_EPS);
        const float* sh = mod3 + (size_t)2 * (6 * D); const float* sc = sh + D;
        const f32x4 g = *(const f32x4*)(gain + col), a_ = *(const f32x4*)(sc + col), b_ = *(const f32x4*)(sh + col);
        f32x4 y = v * rstd * g; y = y * (a_ + 1.0f) + b_;
        v2u o; o.x = cvt_pk_bf16(y.x, y.y); o.y = cvt_pk_bf16(y.z, y.w);
        *(v2u*)(Hout + (size_t)row * D + col) = o;
        if (H32) *(f32x4*)(H32 + (size_t)row * D + col) = y;
    }
    __syncthreads();
}
__device__ __forceinline__ void phase_xm(Frame& F, const float* mu  ) {
    const bf16* Hb = (const bf16*)(F.ws + WS_H); bf16* XM = (bf16*)(F.ws + WS_XM);
    for (int it = F.gw; it < 4 * M; it += F.NGW) {
        const int row = it >> 2, jq = it & 3;
        int pos, len; (void)row_seqinfo(row, pos, len);
        const bool hp = pos > 0, hn = pos + 1 < len;
#pragma unroll
        for (int j2 = 0; j2 < 2; ++j2) {
            const int j = 2 * jq + j2;
            const int col = 4 * F.lane + 256 * j;
            const v2u z2 = {0u, 0u};
            const v2u hr = *(const v2u*)(Hb + (size_t)row * D + col);
            const v2u ar = hp ? *(const v2u*)(Hb + (size_t)(row - 1) * D + col) : z2, br = hn ? *(const v2u*)(Hb + (size_t)(row + 1) * D + col) : z2;
            const f32x4 h = {bflo(hr.x), bfhi(hr.x), bflo(hr.y), bfhi(hr.y)}, a = {bflo(ar.x), bfhi(ar.x), bflo(ar.y), bfhi(ar.y)}, b = {bflo(br.x), bfhi(br.x), bflo(br.y), bfhi(br.y)};
            const f32x4 xx = (a + b) * 0.5f - h;
#pragma unroll
            for (int p = 0; p < 6; ++p) {
                const f32x4 m = *(const f32x4*)(mu + p * D + col); const f32x4 y = h + xx * m;
                v2u o; o.x = cvt_pk_bf16(y.x, y.y); o.y = cvt_pk_bf16(y.z, y.w);
                *(v2u*)(XM + ((size_t)p * M + row) * D + col) = o;
            }
        }
    }
}
constexpr int SCH = 16, NCHUNK = SB / SCH;
__device__ __forceinline__ int rho0(int hi, int i) { return (i & 3) + 4 * hi + 8 * (i >> 2); }
__device__ __forceinline__ int chunk_row0(int b, int d, int c) { const int sg = 16 * c; if (sg < CTXL) return b * SB + SEQ + (d ? CTXL - 1 - sg : sg); const int t = sg - CTXL; return b * SB + (d ? SEQ - 1 - t : t); }
__device__ __forceinline__ float sum64(float v) {
    v = sum16(v);
    { const auto x = __builtin_amdgcn_permlane16_swap(__float_as_uint(v), __float_as_uint(v), false, false); v = __uint_as_float(x[0]) + __uint_as_float(x[1]); }
    { const auto x = __builtin_amdgcn_permlane32_swap(__float_as_uint(v), __float_as_uint(v), false, false); v = __uint_as_float(x[0]) + __uint_as_float(x[1]); }
    return v;
}
__device__ __forceinline__ bf16x8 pack8(float a0, float a1, float a2, float a3, float a4, float a5, float a6, float a7) {
    v4u w; w.x = cvt_pk_bf16_v(a0, a1); w.y = cvt_pk_bf16_v(a2, a3); w.z = cvt_pk_bf16_v(a4, a5); w.w = cvt_pk_bf16_v(a6, a7); return __builtin_bit_cast(bf16x8, w);
}
typedef float f32x16 __attribute__((ext_vector_type(16)));
__device__ __forceinline__ bf16x8 mk8(unsigned a, unsigned b, unsigned c, unsigned d) { return __builtin_bit_cast(bf16x8, (v4u){a, b, c, d}); }
__device__ __forceinline__ constexpr int brev4(int s) { return ((s & 1) << 3) | ((s & 2) << 1) | ((s & 4) >> 1) | ((s & 8) >> 3); }
__device__ __forceinline__ float red16x64(const float (&x)[16], int lane) {
    const bool b3 = lane & 8, b2 = lane & 4, b1 = lane & 2, b0 = lane & 1;
    float y[8], z[4], w[2];
#pragma unroll
    for (int i = 0; i < 8; ++i) { const float keep = b3 ? x[2 * i + 1] : x[2 * i], send = b3 ? x[2 * i] : x[2 * i + 1]; y[i] = keep + dppmov<0x140>(send); }
#pragma unroll
    for (int i = 0; i < 4; ++i) { const float keep = b2 ? y[2 * i + 1] : y[2 * i], send = b2 ? y[2 * i] : y[2 * i + 1]; z[i] = keep + dppmov<0x141>(send); }
#pragma unroll
    for (int i = 0; i < 2; ++i) { const float keep = b1 ? z[2 * i + 1] : z[2 * i], send = b1 ? z[2 * i] : z[2 * i + 1]; w[i] = keep + dppmov<0x4E>(send); }
    float v; { const float keep = b0 ? w[1] : w[0], send = b0 ? w[0] : w[1]; v = keep + dppmov<0xB1>(send); }
    { const auto t = __builtin_amdgcn_permlane16_swap(__float_as_uint(v), __float_as_uint(v), false, false); v = __uint_as_float(t[0]) + __uint_as_float(t[1]); }
    { const auto t = __builtin_amdgcn_permlane32_swap(__float_as_uint(v), __float_as_uint(v), false, false); v = __uint_as_float(t[0]) + __uint_as_float(t[1]); }
    return v;
}
constexpr size_t WS_RS = WS_OPS;
constexpr size_t WS_VF = WS_OPS + 2 * MiB;
__device__ __forceinline__ void phase_rs(Frame& F, int j) {
    const bf16* Kt = (const bf16*)(F.ws + WS_RKV + SZ_ACT); const float* k_k = F.in[22] + (size_t)j * D; float* RS = (float*)(F.ws + WS_RS);
    const int lane = F.lane;
    f32x4 kg[8];
#pragma unroll
    for (int i = 0; i < 8; ++i) kg[i] = *(const f32x4*)(k_k + 32 * lane + 4 * i);
    for (int row = F.gw; row < M; row += F.NGW) {
        const v4u* kr = (const v4u*)(Kt + (size_t)row * D + 32 * lane);
        float acc = 0.f;
#pragma unroll
        for (int i = 0; i < 4; ++i) { const v4u t = kr[i];
            const float x0 = bflo(t.x) * kg[2 * i][0], x1 = bfhi(t.x) * kg[2 * i][1], x2 = bflo(t.y) * kg[2 * i][2], x3 = bfhi(t.y) * kg[2 * i][3];
            const float x4 = bflo(t.z) * kg[2 * i + 1][0], x5 = bfhi(t.z) * kg[2 * i + 1][1], x6 = bflo(t.w) * kg[2 * i + 1][2], x7 = bfhi(t.w) * kg[2 * i + 1][3];
            acc += x0 * x0 + x1 * x1 + x2 * x2 + x3 * x3 + x4 * x4 + x5 * x5 + x6 * x6 + x7 * x7; }
        acc += dppmov<0xB1>(acc);
        if (!(lane & 1)) RS[(size_t)row * 32 + (lane >> 1)] = __builtin_amdgcn_rsqf(fmaxf(acc, 1e-24f));
    }
}
constexpr int FS_NS = 8, FS_SLOT = 11776, FS_A4 = 4352, FS_AW = 8448, FS_A23 = 9472, FS_GAM = 10496, FS_V = 10752;
constexpr int FS_SCR = FS_NS * FS_SLOT, FS_SCRSZ = 5440, FS_FLAGS = FS_SCR + 6 * FS_SCRSZ;
static_assert(FS_FLAGS + 64 <= RING_BYTES, "fused scan LDS");
__device__ __forceinline__ bf16x8 fs_frag(const LAS unsigned char* base, int mb, int jj, int m, int g) {
    const v2u lo = *(const LAS v2u*)(base + mb * 2176 + (8 * jj + g) * 136 + m * 8), hh = *(const LAS v2u*)(base + mb * 2176 + (8 * jj + 4 + g) * 136 + m * 8);
    return __builtin_bit_cast(bf16x8, (v4u){lo.x, lo.y, hh.x, hh.y});
}
__device__ __forceinline__ void phase_scanfused(Frame& F, int j, const bf16* Vsrc) {
    const bf16* R = (const bf16*)(F.ws + WS_RKV); const bf16* Kt = (const bf16*)(F.ws + WS_RKV + SZ_ACT);
    const unsigned short* DEC = (const unsigned short*)(F.ws + WS_DEC); const bf16* AA = (const bf16*)(F.ws + WS_AA);
    const float* k_k = F.in[22] + (size_t)j * D; const float* k_a = F.in[23] + (size_t)j * D; const float* r_k = F.in[24] + (size_t)j * D;
    float* BON = (float*)(F.ws + WS_BON); bf16* Y = (bf16*)(F.ws + WS_Y);
    const int lane = F.lane, wave = F.wave, n16 = lane & 15, g = lane >> 4;
    LAS unsigned char* slots = F.lds + RING_OFF;
    volatile LAS unsigned* flg = (volatile LAS unsigned*)(F.lds + RING_OFF + FS_FLAGS);
    for (int u = F.vcu; u < 256; u += F.G) {
        const int chain = u >> 1, vh = u & 1, d = chain & 1, h = (chain >> 1) & 31, b = chain >> 6;
        const int dstep = d ? -1 : 1; const size_t dofs = (size_t)d * M * D;
        if (F.tid < 16) flg[F.tid] = 0u;
        __syncthreads();
        if (wave >= 2) {
            LAS unsigned char* scr = slots + FS_SCR + (wave - 2) * FS_SCRSZ;
            LAS float* GL = (LAS float*)scr;
            LAS float* TL = (LAS float*)(scr + 4352);
            const int ch = h * 64 + lane;
            const float kkg = k_k[ch], kag = k_a[ch], rkg = r_k[ch];
            const int wofs = (lane >> 2) * 136 + (lane & 3) * 2;
            const int vofs = h * 128 + lane * 2;
            const __amdgpu_buffer_rsrc_t rR = __builtin_amdgcn_make_buffer_rsrc((void*)R, 0, 0x7fffffff, 0x00020000), rK = __builtin_amdgcn_make_buffer_rsrc((void*)Kt, 0, 0x7fffffff, 0x00020000);
            const __amdgpu_buffer_rsrc_t rA = __builtin_amdgcn_make_buffer_rsrc((void*)(AA + dofs), 0, 0x7fffffff, 0x00020000), rW = __builtin_amdgcn_make_buffer_rsrc((void*)(DEC + dofs), 0, 0x7fffffff, 0x00020000);
            const float* RS = (const float*)(F.ws + WS_RS);
            while (true) {
                int c; { unsigned old_; const unsigned one_ = (lane == 0) ? 1u : 0u, addr_ = (unsigned)(size_t)(F.lds + RING_OFF + FS_FLAGS + 40);
                    asm volatile("ds_add_rtn_u32 %0, %1, %2\n\ts_waitcnt lgkmcnt(0)" : "=v"(old_) : "v"(addr_), "v"(one_) : "memory"); c = __builtin_amdgcn_readfirstlane((int)old_); }
                if (c >= NCHUNK) break;
                const int row0 = chunk_row0(b, d, c);
                unsigned short rb[16], kb_[16], ab[16], wf[16];
#pragma unroll
                for (int s = 0; s < 16; ++s) { const int so = (row0 + dstep * s) * (D * 2);
                    rb[s] = __builtin_amdgcn_raw_buffer_load_b16(rR, vofs, so, 0); kb_[s] = __builtin_amdgcn_raw_buffer_load_b16(rK, vofs, so, 0);
                    ab[s] = __builtin_amdgcn_raw_buffer_load_b16(rA, vofs, so, 0); wf[s] = __builtin_amdgcn_raw_buffer_load_b16(rW, vofs, so, 0); }
                const float rsv = RS[(size_t)(row0 + dstep * (lane & 15)) * 32 + h];
                const size_t vo_ = (size_t)(row0 + dstep * (lane >> 2)) * D + h * 64 + vh * 32 + (lane & 3) * 8;
                v4u vreg = *(const v4u*)(Vsrc + vo_);
                if (j > 0) {
                    const v4u v0r = *(const v4u*)((const bf16*)(F.ws + WS_V0) + vo_), vgr = *(const v4u*)((const bf16*)(F.ws + WS_VG) + vo_);
                    v4u o;
                    o.x = cvt_pk_bf16(bflo(vreg.x) + (bflo(v0r.x) - bflo(vreg.x)) * bflo(vgr.x), bfhi(vreg.x) + (bfhi(v0r.x) - bfhi(vreg.x)) * bfhi(vgr.x));
                    o.y = cvt_pk_bf16(bflo(vreg.y) + (bflo(v0r.y) - bflo(vreg.y)) * bflo(vgr.y), bfhi(vreg.y) + (bfhi(v0r.y) - bfhi(vreg.y)) * bfhi(vgr.y));
                    o.z = cvt_pk_bf16(bflo(vreg.z) + (bflo(v0r.z) - bflo(vreg.z)) * bflo(vgr.z), bfhi(vreg.z) + (bfhi(v0r.z) - bfhi(vreg.z)) * bfhi(vgr.z));
                    o.w = cvt_pk_bf16(bflo(vreg.w) + (bflo(v0r.w) - bflo(vreg.w)) * bflo(vgr.w), bfhi(vreg.w) + (bfhi(v0r.w) - bfhi(vreg.w)) * bfhi(vgr.w));
                    vreg = o;
                    if (d == 0) *(v4u*)((bf16*)(F.ws + WS_VF) + vo_) = o;
                }
                if (c >= FS_NS) { const unsigned need = (unsigned)(c - FS_NS + 1); unsigned sp = 0;
                    while (true) { const unsigned d0 = flg[8], d1 = flg[9]; if ((d0 < d1 ? d0 : d1) >= need || ++sp > (1u << 20)) break; __builtin_amdgcn_s_sleep(2); } }
                asm volatile("" ::: "memory");
                LAS unsigned char* sl = slots + (c % FS_NS) * FS_SLOT;
                float rf[16], kf[16], af[16];
#pragma unroll
                for (int s = 0; s < 16; ++s) { rf[s] = bflo(rb[s]); kf[s] = bflo(kb_[s]); af[s] = bflo(ab[s]); }
                if ((c & 1) == vh) {
                    float xs[16];
#pragma unroll
                    for (int s = 0; s < 16; ++s) { const float kd = kf[s] * (1.f + (af[s] - 1.f) * kag); xs[s] = rf[s] * kd * rkg; }
                    const float bnv = red16x64(xs, lane);
                    if (lane < 16) BON[((size_t)d * M + (row0 + dstep * brev4(lane))) * 32 + h] = bnv;
                }
                float G = 1.f; unsigned qprev = 0u, zprev = 0u;
#pragma unroll
                for (int s2 = 0; s2 < 8; ++s2) {
                    float pv[2], rv[2], qv[2], zv[2];
#pragma unroll
                    for (int e = 0; e < 2; ++e) { const int s = 2 * s2 + e;
                        const float r = rf[s], kx = kf[s], a = af[s]; const _Float16 wh = __builtin_bit_cast(_Float16, wf[s]);
                        const float kk = kx * kkg * __uint_as_float((unsigned)__builtin_amdgcn_readlane((int)__float_as_uint(rsv), s));
                        const float bb = kk * a, kd = kx * (1.f + (a - 1.f) * kag);
                        const float gp = G; G = __builtin_fmaf(-G, (float)wh, G); const float inv = __builtin_amdgcn_rcpf(G);
                        pv[e] = gp * kk; rv[e] = G * r; qv[e] = bb * inv; zv[e] = kd * inv; }
                    const unsigned pp = cvt_pk_bf16(pv[0], pv[1]), rr = cvt_pk_bf16(rv[0], rv[1]), qq = cvt_pk_bf16(qv[0], qv[1]), zz = cvt_pk_bf16(zv[0], zv[1]);
                    const int s = 2 * s2;
                    *(LAS unsigned short*)(sl + wofs + s * 8) = (unsigned short)(pp & 0xffffu); *(LAS unsigned short*)(sl + wofs + s * 8 + 8) = (unsigned short)(pp >> 16);
                    *(LAS unsigned short*)(sl + 2176 + wofs + s * 8) = (unsigned short)(rr & 0xffffu); *(LAS unsigned short*)(sl + 2176 + wofs + s * 8 + 8) = (unsigned short)(rr >> 16);
                    *(LAS unsigned short*)(scr + wofs + s * 8) = (unsigned short)(qq & 0xffffu); *(LAS unsigned short*)(scr + wofs + s * 8 + 8) = (unsigned short)(qq >> 16);
                    *(LAS unsigned short*)(scr + 2176 + wofs + s * 8) = (unsigned short)(zz & 0xffffu); *(LAS unsigned short*)(scr + 2176 + wofs + s * 8 + 8) = (unsigned short)(zz >> 16);
                    if (s2 & 1) { *(LAS v2u*)(sl + FS_A4 + lane * 8 + (s2 >> 1) * 1024) = (v2u){qprev ^ 0x80008000u, qq ^ 0x80008000u}; *(LAS v2u*)(sl + FS_A4 + lane * 8 + (s2 >> 1) * 1024 + 512) = (v2u){zprev, zz}; }
                    else { qprev = qq; zprev = zz; }
                }
                *(LAS float*)(sl + FS_GAM + lane * 4) = G;
                *(LAS v4u*)(sl + FS_V + lane * 16) = vreg;
                asm volatile("s_waitcnt lgkmcnt(0)" ::: "memory");
                f32x4 gt[4];
#pragma unroll
                for (int t = 0; t < 4; ++t) {
                    f32x4 acc = {0.f, 0.f, 0.f, 0.f};
#pragma unroll
                    for (int jj = 0; jj < 2; ++jj) acc = __builtin_amdgcn_mfma_f32_16x16x32_bf16(fs_frag(scr, t >> 1, jj, n16, g), fs_frag(sl, t & 1, jj, n16, g), acc, 0, 0, 0);
                    gt[t] = acc;
                }
                asm volatile("s_waitcnt lgkmcnt(0)" ::: "memory");
#pragma unroll
                for (int r = 0; r < 4; ++r) GL[(4 * g + r) * 33 + n16] = gt[0][r];
                asm volatile("s_waitcnt lgkmcnt(0)" ::: "memory");
                if (lane < 16) {
                    f32x2 Np[56]; float Ns[8];
                    { int pi = 0;
#pragma unroll
                      for (int s = 0; s < 15; ++s) {
                          if (!(s & 1)) Ns[s >> 1] = GL[s * 33 + s + 1];
#pragma unroll
                          for (int m = (s >> 1) + 1; m < 8; ++m) { Np[pi] = (f32x2){GL[s * 33 + 2 * m], GL[s * 33 + 2 * m + 1]}; ++pi; }
                      } }
                    f32x2 ac[8];
#pragma unroll
                    for (int m = 0; m < 8; ++m) ac[m] = (f32x2){(lane == 2 * m) ? 1.f : 0.f, (lane == 2 * m + 1) ? 1.f : 0.f};
                    { int pi = 0;
#pragma unroll
                      for (int s = 0; s < 15; ++s) {
                          const float Ts = (s & 1) ? ac[s >> 1].y : ac[s >> 1].x;
                          if (!(s & 1)) ac[s >> 1].y -= Ts * Ns[s >> 1];
                          const f32x2 tv = {Ts, Ts};
#pragma unroll
                          for (int m = (s >> 1) + 1; m < 8; ++m) { ac[m] -= tv * Np[pi]; ++pi; }
                      } }
#pragma unroll
                    for (int t = 0; t < 16; ++t) TL[lane * 17 + t] = (t & 1) ? ac[t >> 1].y : ac[t >> 1].x;
                }
                asm volatile("s_waitcnt lgkmcnt(0)" ::: "memory");
                {   const int m = n16;
                    float aw[8], a23[8];
#pragma unroll
                    for (int i = 0; i < 4; ++i) {
                        const int s = 4 * g + i;
                        const float gzp = gt[2][i], gzr = gt[3][i], gqr = gt[1][i], tv_ = TL[s * 17 + m];
                        aw[i] = (s < m) ? gzp : 0.f;
                        aw[4 + i] = (s <= m) ? gzr : 0.f;
                        a23[i] = tv_;
                        a23[4 + i] = (s <= m) ? -gqr : 0.f;
                    }
                    *(LAS bf16x8*)(sl + FS_AW + lane * 16) = pack8(aw[0], aw[1], aw[2], aw[3], aw[4], aw[5], aw[6], aw[7]);
                    *(LAS bf16x8*)(sl + FS_A23 + lane * 16) = pack8(a23[0], a23[1], a23[2], a23[3], a23[4], a23[5], a23[6], a23[7]);
                }
                asm volatile("s_waitcnt lgkmcnt(0)" ::: "memory");
                if (lane == 0) flg[c % FS_NS] = (unsigned)(c + 1);
            }
        } else {
            f32x4 S0 = {0.f, 0.f, 0.f, 0.f}, S1 = S0, S2 = S0, S3 = S0;
            const f32x4 z4 = {0.f, 0.f, 0.f, 0.f};
            __builtin_amdgcn_s_setprio(2);
            for (int c = 0; c < NCHUNK; ++c) {
                { unsigned sp = 0; while (flg[c % FS_NS] != (unsigned)(c + 1) && ++sp < (1u << 20)) __builtin_amdgcn_s_sleep(1); }
                asm volatile("" ::: "memory");
                const LAS unsigned char* sl = slots + (c % FS_NS) * FS_SLOT;
                bf16x8 a1[4], a4[4];
#pragma unroll
                for (int q = 0; q < 4; ++q) {
                    a1[q] = fs_frag(sl, q >> 1, q & 1, n16, g);
                    const v2u lo = *(const LAS v2u*)(sl + FS_A4 + g * 1024 + (16 * q + n16) * 8), hh = *(const LAS v2u*)(sl + FS_A4 + g * 1024 + 512 + (16 * q + n16) * 8);
                    a4[q] = __builtin_bit_cast(bf16x8, (v4u){lo.x, lo.y, hh.x, hh.y});
                }
                const bf16x8 awm = *(const LAS bf16x8*)(sl + FS_AW + lane * 16), a23 = *(const LAS bf16x8*)(sl + FS_A23 + lane * 16);
                f32x4 gam[4];
#pragma unroll
                for (int kb = 0; kb < 4; ++kb) gam[kb] = *(const LAS f32x4*)(sl + FS_GAM + (kb * 16 + 4 * g) * 4);
                unsigned vv[4];
#pragma unroll
                for (int i = 0; i < 4; ++i) vv[i] = *(const LAS unsigned short*)(sl + FS_V + (4 * g + i) * 64 + (16 * wave + n16) * 2);
                asm volatile("s_waitcnt lgkmcnt(0)" ::: "memory");
                if (lane == 0) flg[8 + wave] = (unsigned)(c + 1);
                const unsigned v01 = vv[0] | (vv[1] << 16), v23 = vv[2] | (vv[3] << 16);
                const bf16x8 VL = mk8(v01, v23, 0u, 0u), VU = mk8(0u, 0u, v01, v23);
                const bf16x8 sb0 = mk8(cvt_pk_bf16_v(S0[0], S0[1]), cvt_pk_bf16_v(S0[2], S0[3]), cvt_pk_bf16_v(S1[0], S1[1]), cvt_pk_bf16_v(S1[2], S1[3]));
                const bf16x8 sb1 = mk8(cvt_pk_bf16_v(S2[0], S2[1]), cvt_pk_bf16_v(S2[2], S2[3]), cvt_pk_bf16_v(S3[0], S3[1]), cvt_pk_bf16_v(S3[2], S3[3]));
                f32x4 accP = __builtin_amdgcn_mfma_f32_16x16x32_bf16(awm, VL, z4, 0, 0, 0);
                f32x4 accR = __builtin_amdgcn_mfma_f32_16x16x32_bf16(awm, VU, z4, 0, 0, 0);
                accP = __builtin_amdgcn_mfma_f32_16x16x32_bf16(a1[0], sb0, accP, 0, 0, 0);
                accR = __builtin_amdgcn_mfma_f32_16x16x32_bf16(a1[2], sb0, accR, 0, 0, 0);
                accP = __builtin_amdgcn_mfma_f32_16x16x32_bf16(a1[1], sb1, accP, 0, 0, 0);
                accR = __builtin_amdgcn_mfma_f32_16x16x32_bf16(a1[3], sb1, accR, 0, 0, 0);
                const bf16x8 RL = mk8(cvt_pk_bf16_v(accP[0], accP[1]), cvt_pk_bf16_v(accP[2], accP[3]), 0u, 0u);
                const f32x4 acc2 = __builtin_amdgcn_mfma_f32_16x16x32_bf16(a23, RL, z4, 0, 0, 0);
                const unsigned u01 = cvt_pk_bf16_v(acc2[0], acc2[1]), u23 = cvt_pk_bf16_v(acc2[2], acc2[3]);
                const bf16x8 UV = mk8(u01, u23, v01, v23), UU = mk8(0u, 0u, u01, u23);
                S0 = __builtin_amdgcn_mfma_f32_16x16x32_bf16(a4[0], UV, S0, 0, 0, 0);
                S1 = __builtin_amdgcn_mfma_f32_16x16x32_bf16(a4[1], UV, S1, 0, 0, 0);
                S2 = __builtin_amdgcn_mfma_f32_16x16x32_bf16(a4[2], UV, S2, 0, 0, 0);
                S3 = __builtin_amdgcn_mfma_f32_16x16x32_bf16(a4[3], UV, S3, 0, 0, 0);
                accR = __builtin_amdgcn_mfma_f32_16x16x32_bf16(a23, UU, accR, 0, 0, 0);
                const int row0 = chunk_row0(b, d, c);
#pragma unroll
                for (int r = 0; r < 4; ++r) Y[dofs + (size_t)(row0 + dstep * (4 * g + r)) * D + h * 64 + vh * 32 + 16 * wave + n16] = (bf16)(cvt_pk_bf16_v(accR[r], 0.f) & 0xffffu);
                S0 *= gam[0]; S1 *= gam[1]; S2 *= gam[2]; S3 *= gam[3];
            }
            __builtin_amdgcn_s_setprio(0);
        }
        __syncthreads();
    }
}
__device__ __forceinline__ void phase_readout(Frame& F, int j, const bf16* Vsrc, int lat_only) {
    const bf16* GG = (const bf16*)(F.ws + WS_GG); const bf16* Y = (const bf16*)(F.ws + WS_Y); const float* BON = (const float*)(F.ws + WS_BON);
    bf16* O = (bf16*)(F.ws + WS_O);
    const float* ln_g = F.in[25] + (size_t)j * D; const float* ln_b = F.in[26] + (size_t)j * D;
    const int nrows = lat_only ? NB * SEQ : M;
    for (int it = F.gw; it < 4 * nrows; it += F.NGW) {
        const int ri = it >> 2, jq = it & 3;
        const int row = lat_only ? (ri / SEQ) * SB + (ri % SEQ) : ri;
#pragma unroll
        for (int j2 = 0; j2 < 2; ++j2) {
            const int jj = 2 * jq + j2;
            const int col = 4 * F.lane + 256 * jj; const size_t o = (size_t)row * D + col; const int head = col >> 6;
            const v2u y0r = *(const v2u*)(Y + o), y1r = *(const v2u*)(Y + (size_t)M * D + o);
            const f32x4 y = (f32x4){bflo(y0r.x) + bflo(y1r.x), bfhi(y0r.x) + bfhi(y1r.x), bflo(y0r.y) + bflo(y1r.y), bfhi(y0r.y) + bfhi(y1r.y)};
            const float bon = BON[(size_t)row * 32 + head] + BON[((size_t)M + row) * 32 + head];
            const float mean = sum16((y.x + y.y) + (y.z + y.w)) * (1.f / 64.f);
            const f32x4 dy = y - mean;
            const float var = sum16((dy.x * dy.x + dy.y * dy.y) + (dy.z * dy.z + dy.w * dy.w)) * (1.f / 64.f);
            const float rs = rsqrtf(var + GN_EPS);
            const v2u vr = *(const v2u*)(Vsrc + o), gr = *(const v2u*)(GG + o);
            const f32x4 v = {bflo(vr.x), bfhi(vr.x), bflo(vr.y), bfhi(vr.y)}, g = {bflo(gr.x), bfhi(gr.x), bflo(gr.y), bfhi(gr.y)};
            const f32x4 lg = *(const f32x4*)(ln_g + col), lb = *(const f32x4*)(ln_b + col);
            const f32x4 ov = (dy * rs * lg + lb + v * bon) * g;
            v2u w; w.x = cvt_pk_bf16(ov.x, ov.y); w.y = cvt_pk_bf16(ov.z, ov.w);
            *(v2u*)(O + o) = w;
        }
    }
}
__device__ __forceinline__ float qk_bound(const float* qg, const float* kg, int lane) {
    float a = fmaxf(fabsf(qg[lane]), fabsf(qg[lane + 64])), b = fmaxf(fabsf(kg[lane]), fabsf(kg[lane + 64]));
#pragma unroll
    for (int o = 1; o < 64; o <<= 1) { a = fmaxf(a, __shfl_xor(a, o)); b = fmaxf(b, __shfl_xor(b, o)); }
    return 128.f * a * b * 1.01f;
}
constexpr float FIXM_LIMIT = 45.f / (att::SCALE * 1.4426950408889634f);
__device__ __forceinline__ void phase_attn_gqa(Frame& F) {
    const bf16* QKV = (const bf16*)(F.ws + WS_QKV); bf16* O = (bf16*)(F.ws + WS_O);
    att::NaInfo na{0, 0, nullptr, 0.f};
    na.mfix = qk_bound(F.in[37], F.in[38], F.lane);
    const bool fixm = na.mfix < FIXM_LIMIT;
    for (int u = F.vcu; u < 512 + 32; u += F.G) {
        int b, h, qrow, NT, first0;
        if (u < 512) { const int kvg = u >> 6; b = kvg >> 2; h = (kvg & 3) * 4 + ((u >> 4) & 3); qrow = (u & 15) * 256; NT = SB / 64; first0 = 0; }
        else { const int v = u - 512; b = v >> 4; h = v & 15; qrow = SEQ; NT = CTXL / 64; first0 = SEQ; }
        const int kvh = h >> 2;
        const bf16* Qb = QKV + ((size_t)b * SB + qrow) * 3072 + h * HD;
        const bf16* Kh = QKV + (size_t)b * SB * 3072 + 2048 + kvh * HD; const bf16* Vh = Kh + 512;
        if (fixm) att::attn_unit<3072, 3072, 2048, false, true>(Qb, Kh, Vh, O + ((size_t)b * SB + qrow) * D + h * HD, NT, NT, first0, 0, (char*)F.ldsg + RING_OFF, na);
        else att::attn_unit<3072, 3072, 2048, false, false>(Qb, Kh, Vh, O + ((size_t)b * SB + qrow) * D + h * HD, NT, NT, first0, 0, (char*)F.ldsg + RING_OFF, na);
    }
}
__device__ __forceinline__ void phase_attn_na(Frame& F, const float* rpb  ) {
    const bf16* QKV = (const bf16*)(F.ws + WS_QKV); bf16* O = (bf16*)(F.ws + WS_O);
    float* tab = (float*)((char*)F.ldsg + RING_OFF + att::SHM_ATTN);
    const bool bal = (F.G == 256);
    for (int k = 0;; ++k) {
        int u;
        if (bal) { if (k < 2) u = F.vcu + 256 * k; else { const int q = F.vcu & 15; if (k > 2 || (q != 0 && q != 15)) break; u = 512 + (F.vcu >> 4) * 2 + (q == 15 ? 1 : 0); } }
        else { u = F.vcu + F.G * k; if (u >= 512 + 32) break; }
        int b, h, qrow, NT, second0 = 0; att::NaInfo na{0, 0, tab, 0.f};
        if (u < 512) {
            b = u >> 8; h = (u >> 4) & 15; const int qb = u & 15; qrow = qb * 256;
            const int r0 = qb * 4; int rs_lo = r0 - 4; rs_lo = rs_lo < 0 ? 0 : (rs_lo > 56 ? 56 : rs_lo); int rs_hi = r0 + 3 - 4; rs_hi = rs_hi < 0 ? 0 : (rs_hi > 56 ? 56 : rs_hi);
            int nlat = rs_hi + 8 - rs_lo;
            if (nlat & 1) { if (rs_hi + 8 < 64) nlat += 1; else { rs_lo -= 1; nlat += 1; } }
            na.r0 = r0; na.rs_lo = rs_lo; NT = 4 + nlat; second0 = rs_lo * 64;
        } else { const int v = u - 512; b = v >> 4; h = v & 15; qrow = SEQ; NT = 4; }
        for (int i = F.tid; i < 15 * 31; i += 512) tab[64 + i] = rpb[h * 465 + i] * (1.0f / att::SCALE);
        __syncthreads();
        const bf16* Qb = QKV + ((size_t)b * SB + qrow) * 6144 + h * HD;
        const bf16* Kh = QKV + (size_t)b * SB * 6144 + 2048 + h * HD; const bf16* Vh = Kh + 2048;
        att::attn_unit_simple<6144, 6144, 2048, true>(Qb, Kh, Vh, O + ((size_t)b * SB + qrow) * D + h * HD, NT, 4, SEQ, second0, (char*)F.ldsg + RING_OFF, na);
    }
}
__device__ __forceinline__ void phase_convfix(Frame& F, const float* cw  , const float* cb  , int lat_only) {
    const float* HALO = (const float*)(F.ws + WS_HALO); bf16* ACT = (bf16*)(F.ws + WS_ACT);
    for (int wi = F.gw; wi < 2 * (M / 64) * 22; wi += F.NGW) {
        const int it = wi / 22, i = wi - it * 22;
        const int g = it >> 1, last = it & 1, row = g * 64 + (last ? 63 : 0);
        int pos, len; const int s_ = row_seqinfo(row, pos, len);
        if (lat_only && s_ == 2) continue;
        const bool hp = pos > 0, hn = pos + 1 < len;
        const float* pm = HALO + (size_t)(last ? g * 4 + 2 : (g - 1) * 4 + 3) * DFF2;
        const float* p0 = HALO + (size_t)(last ? g * 4 + 3 : g * 4 + 0) * DFF2;
        const float* pp = HALO + (size_t)(last ? (g + 1) * 4 + 0 : g * 4 + 1) * DFF2;
        const f32x4 z = {0.f, 0.f, 0.f, 0.f};
        {
            const int f = (i * 64 + F.lane) * 4;
            f32x4 r[2];
#pragma unroll
            for (int half = 0; half < 2; ++half) {
                const int c = f + half * DFF;
                const f32x4 um = hp ? *(const f32x4*)(pm + c) : z, u0 = *(const f32x4*)(p0 + c), up = hn ? *(const f32x4*)(pp + c) : z;
                r[half] = *(const f32x4*)(cb + c) + *(const f32x4*)(cw + c) * um + *(const f32x4*)(cw + DFF2 + c) * u0 + *(const f32x4*)(cw + 2 * DFF2 + c) * up;
            }
            float o[4];
#pragma unroll
            for (int e = 0; e < 4; ++e) o[e] = r[0][e] * r[1][e] * __builtin_amdgcn_rcpf(1.f + __expf(-r[0][e]));
            v2u w; w.x = cvt_pk_bf16(o[0], o[1]); w.y = cvt_pk_bf16(o[2], o[3]);
            *(v2u*)(ACT + (size_t)row * DFF + f) = w;
        }
    }
}

constexpr int PH_PER_LAYER = 12, N_PHASES = 1 + DEPTH * PH_PER_LAYER;
__global__ void __launch_bounds__(512, 2) fwd(Args args) {
    extern __shared__ __attribute__((aligned(16))) unsigned char lds[];
    Frame F;
    F.lds = (LAS unsigned char*)lds; F.ldsg = lds;
    F.tid = threadIdx.x; F.lane = F.tid & 63; F.wave = __builtin_amdgcn_readfirstlane(F.tid >> 6);
    F.G = gridDim.x; { const int bx = blockIdx.x; F.vcu = (F.G % 8 == 0) ? (bx % 8) * (F.G / 8) + bx / 8 : bx; }
    F.gw = F.vcu * 8 + F.wave; F.NGW = F.G * 8;
    F.ws = args.ws; F.in = args.in; F.out = args.out;
    volatile LAS unsigned* MISC = (volatile LAS unsigned*)(F.lds + MISC_OFF);
    for (int u = F.tid; u < (LDS_BYTES - LDSCTL_OFF) / 4; u += 512) ((LAS unsigned*)(F.lds + LDSCTL_OFF))[u] = 0u;
    __syncthreads();
    const int lo = args.ph_lo, hi = args.ph_hi;
    XcdBarrier bar; bar.bar = (unsigned*)(F.ws + WS_CTL) + CW_BAR; bar.x = 0; bar.st = nullptr;
    if (hi - lo > 1) bar = xcd_barrier_post((unsigned*)(F.ws + WS_CTL) + CW_BAR, MISC + 8);
#ifndef PHMASK
#define PHMASK 0xFFFFFFFFu
#endif
#ifndef REPMASK
#define REPMASK 0u
#endif
#define CT(b) ((PHMASK >> (b)) & 1u)
#define NREP(b) (CT(b) ? (((REPMASK >> (b)) & 1u) ? 2 : 1) : 0)
#define REPF(b) for (int rep_ = 0; rep_ < NREP(b); ++rep_)
#define IN(k) (lo <= (k) && (k) < hi)
#define REFRESH() do { F.tid = ltid(); F.lane = F.tid & 63; F.wave = __builtin_amdgcn_readfirstlane(F.tid >> 6); F.gw = F.vcu * 8 + F.wave; } while (0)
#define SEAM(k) do { if (IN((k) + 1)) xcd_barrier(bar); } while (0)
    const float* MOD = (const float*)(F.ws + WS_MOD);
    bf16* X = (bf16*)(F.ws + WS_X);
    bf16* H = (bf16*)(F.ws + WS_H); bf16* Obuf = (bf16*)(F.ws + WS_O);

    if (IN(0)) { REFRESH(); REPF(0) pro_transposes(F); REPF(1) pro_small(F); __syncthreads(); REPF(3) pro_mod(F); SEAM(0); }

    for (int l = 0; l < DEPTH; ++l) {
        const int kind = l % 3, j = l / 3, P = 1 + l * PH_PER_LAYER;
        const float* modl = MOD + (size_t)l * 3 * 12288;
        const int lat3 = (l == DEPTH - 1) ? 1 : 0;
        if (IN(P + 0)) { REFRESH(); REPF(4) phase_norm(F, F.in[6] + (size_t)l * D, modl, H, nullptr, l > 0 ? 11 : 0, modl - 3 * 12288 + 2 * 12288 + 5 * D, 0, l == 0 ? F.in[0] : nullptr, l == 0 ? F.in[2] : nullptr); SEAM(P + 0); }
        if (IN(P + 1)) { REFRESH();
            if (kind == 0) { REPF(5) phase_xm(F, F.in[12] + (size_t)j * 6 * D); }
            else REPF(6) {
                pg8::Gemm g{H, (const bf16*)(F.ws + (kind == 1 ? WS_NAQKVT : WS_GAQKVT)), D};
                pg8::MultiOrder S{&g_ord[kind == 1 ? ORD_N24 : ORD_N12], NMB, F.G, (int)blockIdx.x, 0, 32};
                EpiQKV E{(bf16*)(F.ws + WS_QKV), kind == 1 ? 6144 : 3072, kind == 1 ? 16 : 10, 8, F.in[kind == 1 ? 32 : 37], F.in[kind == 1 ? 33 : 38], kind == 1 ? 0 : 1,
                         (LAS float*)(F.lds + LDSCTL_OFF + 512)};
                pg8::gemm_phase<EpiQKV, pg8::MultiOrder, true, true>(F.lds + RING_OFF, g, S, E);
            }
            SEAM(P + 1);
        }
        if (IN(P + 2) && kind == 0) { REFRESH();
            if (kind == 0) { REPF(7) {
                pg8::Gemm g{(const bf16*)(F.ws + WS_XM), (const bf16*)(F.ws + WS_RWT) + (size_t)j * 28 * 256 * 2048, D};
                pg8::MultiOrder S{&g_ord[j == 0 ? ORD_RW0 : ORD_RW1], NMB, F.G, (int)blockIdx.x, 0, 32};
                EpiGen E{F.ws, g_od[j == 0 ? OD_RW0 : OD_RW1], F.in};
                pg8::gemm_phase<EpiGen, pg8::MultiOrder, true, true>(F.lds + RING_OFF, g, S, E); }
            }
            SEAM(P + 2);
        }
        if (IN(P + 3)) { REFRESH();
            if (kind == 0) { REPF(10) {
                pg8::Gemm g{(const bf16*)(F.ws + WS_L1O), (const bf16*)(F.ws + WS_RL2T) + (size_t)j * 48 * 256 * 256, 256};
                pg8::Lora2Order S{&g_ord[j == 0 ? ORD_L20 : ORD_L21], NMB, F.G, (int)blockIdx.x};
                EpiGen E{F.ws, g_od[j == 0 ? OD_L20 : OD_L21], F.in};
                pg8::gemm_phase<EpiGen, pg8::Lora2Order, true, true>(F.lds + RING_OFF, g, S, E); }
                REFRESH(); phase_rs(F, j);
            } else if (kind == 1) { REPF(11) phase_attn_na(F, F.in[34]); }
            else { REPF(12) phase_attn_gqa(F); }
            SEAM(P + 3);
        }
        if (kind == 0) {
            const bf16* Vsrc = (const bf16*)(F.ws + (j == 0 ? WS_V0 : WS_RKV + 2 * SZ_ACT));

            if (IN(P + 5)) { REFRESH(); REPF(14) phase_scanfused(F, j, Vsrc); SEAM(P + 5); }
            if (IN(P + 6)) { REFRESH(); REPF(15) phase_readout(F, j, j == 0 ? Vsrc : (const bf16*)(F.ws + WS_VF), lat3); SEAM(P + 6); }
        }
        if (IN(P + 7)) { REFRESH(); if (CT(16)) {
            const size_t wo = (kind == 0) ? (WS_RWOT + (size_t)j * 2048 * 2048 * 2) : (kind == 1 ? WS_NAOT : WS_GAOT);
            pg8::Gemm g{Obuf, (const bf16*)(F.ws + wo), D};
            pg8::SplitCtxOrder S{F.G, (int)blockIdx.x, 32, 8, 4, lat3 ? 0 : 1};
            EpiRes E{X, modl + 2 * D, nullptr, (float*)(F.ws + WS_PART), (l == 0) ? F.in[0] : nullptr};
            pg8::gemm_phase<EpiRes, pg8::SplitCtxOrder, true, true>(F.lds + RING_OFF, g, S, E); }
            SEAM(P + 7);
        }
        if (IN(P + 8)) { REFRESH(); REPF(4) phase_norm(F, F.in[7] + (size_t)l * D, modl + 3 * D, H, nullptr, lat3 ? 0 : 8, modl + 2 * 12288 + 2 * D, lat3); SEAM(P + 8); }
        if (IN(P + 9)) { REFRESH(); REPF(17) {
            pg8::Gemm g{H, (const bf16*)(F.ws + WS_UPT) + (size_t)l * DFF2 * D, D};
            pg8::BlockOrder S{F.G, (int)blockIdx.x, lat3, 32};
            EpiUp E{(bf16*)(F.ws + WS_ACT), (float*)(F.ws + WS_HALO), F.in[9] + (size_t)l * 3 * DFF2, F.in[10] + (size_t)l * DFF2};
            pg8::gemm_phase<EpiUp, pg8::BlockOrder, true, true>(F.lds + RING_OFF, g, S, E); }
            SEAM(P + 9);
        }
        if (IN(P + 10)) { REFRESH(); REPF(18) phase_convfix(F, F.in[9] + (size_t)l * 3 * DFF2, F.in[10] + (size_t)l * DFF2, lat3); SEAM(P + 10); }
        if (IN(P + 11)) { REFRESH(); if (CT(19)) {
            pg8::Gemm g{(const bf16*)(F.ws + WS_ACT), (const bf16*)(F.ws + WS_DNT) + (size_t)l * D * DFF, DFF};
            pg8::SplitCtxOrder S{F.G, (int)blockIdx.x, 88, 11, 8, lat3 ? 0 : 1};
            EpiRes E{X, modl + 5 * D, (l == DEPTH - 1) ? F.out : nullptr, (float*)(F.ws + WS_PART), nullptr};
            pg8::gemm_phase<EpiRes, pg8::SplitCtxOrder, true, true>(F.lds + RING_OFF, g, S, E); }
            SEAM(P + 11);
        }
    }
#undef IN
#undef SEAM
}

extern "C" void kernel_launch(void* const* d_in, const int* in_sizes, int n_in, void* d_out, int out_size, void* d_ws, size_t ws_size, hipStream_t stream) {
    static int grid = 0;
    if (grid == 0) {
        if (n_in != 40 || out_size != NB * SEQ * D || ws_size < WS_END) { fprintf(stderr, "kernel_launch: unexpected shapes (n_in %d out %d ws %zu need %zu)\n", n_in, out_size, ws_size, (size_t)WS_END); grid = -1; return; }
        int dev = 0, cus = 0;
        if (hipGetDevice(&dev) != hipSuccess || hipDeviceGetAttribute(&cus, hipDeviceAttributeMultiprocessorCount, dev) != hipSuccess) { grid = -1; return; }
        if (hipFuncSetAttribute((const void*)fwd, hipFuncAttributeMaxDynamicSharedMemorySize, LDS_BYTES) != hipSuccess) { fprintf(stderr, "kernel_launch: hipFuncSetAttribute failed\n"); grid = -1; return; }
        int per_cu = 0;
        if (hipOccupancyMaxActiveBlocksPerMultiprocessor(&per_cu, (const void*)fwd, 512, LDS_BYTES) != hipSuccess || per_cu < 1) fprintf(stderr, "kernel_launch: occupancy query says %d\n", per_cu);
        (void)hipGetLastError();
        grid = cus;
    }
    if (grid < 0) return;
    (void)hipMemsetAsync((char*)d_ws + WS_CTL, 0, CTL_ZERO_BYTES, stream);
    Args a{};
    for (int i = 0; i < 40; ++i) a.in[i] = (const float*)d_in[i];
    a.out = (float*)d_out; a.ws = (unsigned char*)d_ws;
#if MK_ONE_LAUNCH
    a.ph_lo = 0; a.ph_hi = N_PHASES;
    hipLaunchKernelGGL(fwd, dim3(grid), dim3(512), LDS_BYTES, stream, a);
#else
    for (int ph = 0; ph < N_PHASES; ++ph) {
        if (ph > 0) { const int l = (ph - 1) / PH_PER_LAYER, k = (ph - 1) % PH_PER_LAYER, kind = l % 3, j = l / 3;
            if (kind != 0 && (k == 4 || k == 5 || k == 6)) continue;
            if (kind == 0 && k == 4) continue; }
        a.ph_lo = ph; a.ph_hi = ph + 1;
        hipLaunchKernelGGL(fwd, dim3(grid), dim3(512), LDS_BYTES, stream, a);
    }
#endif
    const hipError_t le = hipPeekAtLastError();
    if (le != hipSuccess) fprintf(stderr, "kernel_launch: launch failed: %s\n", hipGetErrorName(le));
}
```

```cpp
#include <hip/hip_runtime.h>
#include <cstdio>
#include <cstdint>

#ifndef MK_ONE_LAUNCH
#define MK_ONE_LAUNCH 1
#endif

constexpr int D = 2048, NB = 2, SEQ = 4096, CTXL = 256, DEPTH = 4;
constexpr int SB = SEQ + CTXL;
constexpr int M = NB * SB;
constexpr int NMB = M / 256;
constexpr int DFF = 5632, DFF2 = 11264;
constexpr int HD = 128, NH = 16, KVH = 4, KVD = 512;
constexpr int RNH = 32;
constexpr float NORM_EPS = 1e-6f, GN_EPS = 64e-5f;

#define GAS __attribute__((address_space(1)))
#define LAS __attribute__((address_space(3)))
typedef unsigned short bf16;
typedef unsigned v4u __attribute__((ext_vector_type(4)));
typedef unsigned v2u __attribute__((ext_vector_type(2)));
typedef float f32x4 __attribute__((ext_vector_type(4)));
typedef float f32x2 __attribute__((ext_vector_type(2)));
typedef short bf16x8 __attribute__((ext_vector_type(8)));

__device__ __forceinline__ int ltid() { int t = threadIdx.x; asm volatile("" : "+v"(t)); return t; }
__device__ __forceinline__ float bflo(unsigned u) { return __uint_as_float(u << 16); }
__device__ __forceinline__ float bfhi(unsigned u) { return __uint_as_float(u & 0xffff0000u); }
__device__ __forceinline__ unsigned cvt_pk_bf16(float lo, float hi) { unsigned r; asm volatile("v_cvt_pk_bf16_f32 %0, %1, %2" : "=v"(r) : "v"(lo), "v"(hi)); return r; }
typedef __bf16 bf16x2_t __attribute__((ext_vector_type(2)));
__device__ __forceinline__ unsigned cvt_pk_bf16_v(float lo, float hi) { const f32x2 v = {lo, hi}; return __builtin_bit_cast(unsigned, __builtin_convertvector(v, bf16x2_t)); }
__device__ __forceinline__ float sigmoidf_(float x) { return __builtin_amdgcn_rcpf(1.0f + __expf(-x)); }
__device__ __forceinline__ float wave_sum(float v) {
#pragma unroll
    for (int o = 1; o < 64; o <<= 1) v += __shfl_xor(v, o);
    return v;
}
template <int CTRL> __device__ __forceinline__ float dppmov(float v) { return __builtin_bit_cast(float, __builtin_amdgcn_update_dpp(0, __builtin_bit_cast(int, v), CTRL, 0xF, 0xF, true)); }
__device__ __forceinline__ float sum16(float v) {
    v += dppmov<0xB1>(v); v += dppmov<0x4E>(v); v += dppmov<0x141>(v); v += dppmov<0x140>(v); return v;
}

constexpr size_t MiB = 1u << 20;
constexpr size_t WS_CTL = 0, CTL_ZERO_BYTES = 1 * MiB;
constexpr size_t WS_MOD = 1 * MiB;
constexpr size_t WS_X = 2 * MiB;
constexpr size_t WS_H = 70 * MiB;
constexpr size_t WS_O = 104 * MiB;
constexpr size_t WS_V0 = 138 * MiB;
constexpr size_t WS_UPT = 172 * MiB;
constexpr size_t WS_DNT = 348 * MiB;
constexpr size_t WS_RWT = 436 * MiB;
constexpr size_t WS_RL2T = 492 * MiB;
constexpr size_t WS_RWOT = 504 * MiB;
constexpr size_t WS_NAQKVT = 520 * MiB;
constexpr size_t WS_NAOT = 544 * MiB;
constexpr size_t WS_GAQKVT = 552 * MiB;
constexpr size_t WS_GAOT = 564 * MiB;
constexpr size_t WS_S0 = 572 * MiB;
constexpr size_t WS_RKV = WS_S0;
constexpr size_t WS_L1O = WS_S0 + 102 * MiB;
constexpr size_t WS_DEC = WS_S0 + 119 * MiB;
constexpr size_t WS_AA = WS_S0 + 255 * MiB;
constexpr size_t WS_GG = WS_S0 + 323 * MiB;
constexpr size_t WS_VG = WS_S0 + 357 * MiB;
constexpr size_t WS_PART = WS_S0 + 391 * MiB;
constexpr size_t WS_Y = WS_S0 + 435 * MiB;
constexpr size_t WS_XM = WS_S0 + 571 * MiB;
constexpr size_t WS_OPS = WS_S0 + 571 * MiB;
constexpr size_t WS_BON = WS_S0 + 435 * MiB + 72 * MiB;
constexpr size_t WS_H32 = WS_DEC;
constexpr size_t WS_QKV = WS_S0;
constexpr size_t WS_ACT = WS_S0 + 188 * MiB;
constexpr size_t WS_HALO = WS_S0 + 282 * MiB;
constexpr size_t WS_END = WS_S0 + 945 * MiB;
constexpr size_t SZ_ACT = (size_t)M * D * 2;

namespace pg8 {
#define PG8_LAS __attribute__((address_space(3)))
typedef unsigned short bf16_t;
typedef unsigned u32x4 __attribute__((ext_vector_type(4)));
constexpr int BM = 256, BK = 64, HALF = 128, HTB = HALF * BK * 2, STAGE_BYTES = 8 * HTB, NXCD = 8, WGM = 4;

__host__ __device__ __forceinline__ int lds_byte(int r, int c) { const int st = (r >> 4) * 2 + (c >> 5), rr = r & 15, cc = c & 31, ob = rr * 64 + cc * 2; return st * 1024 + (ob ^ (((ob >> 9) & 1) << 5)); }
__host__ __device__ __forceinline__ void stage_rc(int b, int& R, int& C) { const int st = b / 1024, sb = b % 1024, swz = sb ^ (((sb >> 9) & 1) << 5); R = (st >> 1) * 16 + swz / 64; C = (st & 1) * 32 + (swz % 64) / 2; }
__host__ __device__ __forceinline__ int perm32(int rho) { const int n = rho >> 4, i = rho & 15; return 8 * (i >> 2) + 4 * n + (i & 3); }

struct Unit { int pm, pn, lm, ln, sub, kofs, nt, kpart; };
struct Gemm { const bf16_t* A; const bf16_t* Bt; int K; };

struct SubP { int nN, pmBase, pnBase, cum; };
struct OrdTab { int nsub, total, pad0, pad1; SubP sp[8]; };

struct MultiOrder {
    const OrdTab* T; int nM, G, c, lat_only, nt;
    __device__ __forceinline__ bool next(int i, Unit& u) const {
        const int total = lat_only ? T->total / 34 * 32 : T->total;
        const long L = (long)i * G + c; if (L >= total) return false;
        int w = (int)L; { const int q = total / NXCD, r = total % NXCD, xcd = w % NXCD, off = w / NXCD; w = (xcd < r ? xcd * (q + 1) : r * (q + 1) + (xcd - r) * q) + off; }
        int s = 0; const int ns = T->nsub; const int nMe = lat_only ? 32 : nM;
        if (lat_only) { while (s + 1 < ns && w >= T->sp[s + 1].cum / 34 * 32) ++s; }
        else { while (s + 1 < ns && w >= T->sp[s + 1].cum) ++s; }
        const int lw = w - (lat_only ? T->sp[s].cum / 34 * 32 : T->sp[s].cum), nN = T->sp[s].nN;
        const int nig = WGM * nN, gid = lw / nig, fm = gid * WGM, gsz = (nMe - fm) < WGM ? (nMe - fm) : WGM;
        int lm = fm + ((lw % nig) % gsz); const int ln = (lw % nig) / gsz;
        if (lat_only) lm += (lm >= 16) ? 1 : 0;
        u.lm = lm; u.ln = ln; u.sub = s; u.pm = T->sp[s].pmBase + lm; u.pn = T->sp[s].pnBase + ln; u.kofs = 0; u.nt = nt; u.kpart = -1; return true;
    }
};
struct Lora2Order {
    const OrdTab* T; int nM, G, c;
    __device__ __forceinline__ bool next(int i, Unit& u) const {
        const int total = T->total;
        const long L = (long)i * G + c; if (L >= total) return false;
        const int xcd = (int)L % NXCD, off = (int)L / NXCD;
        int s = 0; const int ns = T->nsub;
        while (s + 1 < ns && off >= T->sp[s + 1].cum / NXCD) ++s;
        const int ns8 = ((s + 1 < ns ? T->sp[s + 1].cum : total) - T->sp[s].cum) / NXCD;
        const int lw = xcd * ns8 + (off - T->sp[s].cum / NXCD), nN = T->sp[s].nN;
        const int nig = WGM * nN, gid = lw / nig, fm = gid * WGM, gsz = (nM - fm) < WGM ? (nM - fm) : WGM;
        const int lm = fm + ((lw % nig) % gsz), ln = (lw % nig) / gsz;
        u.lm = lm; u.ln = ln; u.sub = s; u.pm = T->sp[s].pmBase + lm; u.pn = T->sp[s].pnBase + ln; u.kpart = -1;
        u.kofs = (s < 2) ? (ln >> 3) * 128 : 0; u.nt = (s == 2) ? 4 : 2;
        return true;
    }
};
struct BlockOrder {
    int G, c, lat_only, nt;
    __device__ __forceinline__ bool next(int i, Unit& u) const {
        const int nr = lat_only ? 16 : 17, per = nr * 11;
        const long L = (long)i * G + c; if (L >= (long)NXCD * per) return false;
        const int xcd = (int)(L % NXCD), off = (int)(L / NXCD);
        const int bx = xcd >> 2, by = xcd & 3;
        const int nig = WGM * 11, gid = off / nig, fm = gid * WGM, gsz = (nr - fm) < WGM ? (nr - fm) : WGM;
        const int rg = off % nig;
        const int lr = fm + (gsz == WGM ? (rg & (WGM - 1)) : 0), lc = gsz == WGM ? (rg >> 2) : rg;
        int lm = bx * nr + lr; if (lat_only) lm += (lm >= 16) ? 1 : 0;
        const int ln = by * 11 + lc;
        u.lm = lm; u.ln = ln; u.sub = 0; u.pm = lm; u.pn = ln; u.kofs = 0; u.nt = nt; u.kpart = -1;
        return true;
    }
};
struct SplitCtxOrder {
    int G, c, ntFull, KS, ntPart, with_ctx;
    __device__ __forceinline__ bool next(int i, Unit& u) const {
        const long L = (long)i * G + c; const int nfull = 256, total = nfull + (with_ctx ? 16 * KS : 0);
        if (L >= total) return false;
        int w = (int)L; u.sub = 0;
        if (w < nfull) {
            { const int q = nfull / NXCD, xcd = w % NXCD, off = w / NXCD; w = xcd * q + off; }
            const int nig = WGM * 8, gid = w / nig, fm = gid * WGM; const int lml = fm + ((w % nig) % WGM); u.ln = (w % nig) / WGM;
            u.lm = lml + (lml >= 16 ? 1 : 0); u.kofs = 0; u.nt = ntFull; u.kpart = -1;
        } else {
            w -= nfull; const int kp = w % KS, t = w / KS;
            u.lm = (t >> 3) ? 33 : 16; u.ln = t & 7; u.kofs = kp * ntPart * BK; u.nt = ntPart; u.kpart = kp;
        }
        u.pm = u.lm; u.pn = u.ln; return true;
    }
};

template <class Epi, class Sched, bool ALIGN_EPI = false, bool SP2 = false>
__device__ __forceinline__ void gemm_phase(PG8_LAS unsigned char* lds, const Gemm g, const Sched& S, const Epi& E) {
    const int tid = ltid(), wid = __builtin_amdgcn_readfirstlane(tid >> 6), lane = tid & 63, wr = wid >> 2, wc = wid & 3, fr = lane & 15, fq = lane >> 4;
    int K = g.K; asm volatile("" : "+s"(K));
    unsigned voffA[2], voffB[2];
#pragma unroll
    for (int i = 0; i < 2; ++i) { int R, C; stage_rc(tid * 16 + i * 8192, R, C); const int Rb = Epi::PERM ? ((R & ~31) + perm32(R & 31)) : R;
        voffA[i] = (unsigned)(R * K + C) * 2u; voffB[i] = (unsigned)(Rb * K + C) * 2u; }
    const size_t kstep = (size_t)(BK * 2);
    const size_t hstep = (size_t)HALF * K * 2;
    const size_t tstep = 2 * hstep;
    const unsigned ldsw = (unsigned)wid * 1024u;
    const int aoff = lds_byte(wr * 64 + fr, fq * 8), boff = lds_byte(wc * 32 + fr, fq * 8);
#define PG8_SA(b, h) (((b) * 2 + (h)) * HTB)
#define PG8_SB(b, h) ((4 + (b) * 2 + (h)) * HTB)
#define PG8_STAGE(bufoff, gbase, voff) do { _Pragma("unroll") for (int _i = 0; _i < 2; ++_i) \
        __builtin_amdgcn_global_load_lds((const unsigned*)((const char*)(gbase) + (voff)[_i]), (PG8_LAS unsigned*)(lds + (bufoff) + ldsw + _i * 8192), 16, 0, 0); } while (0)
#define PG8_LDA(dst, b, h) do { _Pragma("unroll") for (int m = 0; m < 4; ++m) _Pragma("unroll") for (int k = 0; k < 2; ++k) dst[m][k] = *(const PG8_LAS bf16x8*)(lds + PG8_SA(b, h) + aoff + m * 2048 + k * 1024); } while (0)
#define PG8_LDB(dst, b, h) do { _Pragma("unroll") for (int n = 0; n < 2; ++n) _Pragma("unroll") for (int k = 0; k < 2; ++k) dst[n][k] = *(const PG8_LAS bf16x8*)(lds + PG8_SB(b, h) + boff + n * 2048 + k * 1024); } while (0)
#define PG8_MMA(ai, bj, At, Bt) do { __builtin_amdgcn_s_setprio(1); _Pragma("unroll") for (int m = 0; m < 4; ++m) _Pragma("unroll") for (int n = 0; n < 2; ++n) _Pragma("unroll") for (int k = 0; k < 2; ++k) \
        acc[ai][bj][m][n] = __builtin_amdgcn_mfma_f32_16x16x32_bf16(Bt[n][k], At[m][k], acc[ai][bj][m][n], 0, 0, 0); __builtin_amdgcn_s_setprio(0); } while (0)
#define PG8_WAIT_V(n) asm volatile("s_waitcnt vmcnt(" #n ")" ::: "memory")
#define PG8_WAIT_VF_(nf) asm volatile("s_cmp_eq_u32 %0, 0\n\ts_cbranch_scc1 .LW%=\n\ts_waitcnt vmcnt(" #nf ")\n\ts_branch .LE%=\n.LW%=:\n\ts_waitcnt vmcnt(8)\n.LE%=:" :: "s"(fresh) : "memory", "scc")
#define PG8_WAIT_VF(n16, n8) do { if constexpr (Epi::MIN_VM == 16) PG8_WAIT_VF_(n16); else if constexpr (Epi::MIN_VM == 8) PG8_WAIT_VF_(n8); else PG8_WAIT_V(8); } while (0)
#define PG8_WAIT_L(n) asm volatile("s_waitcnt lgkmcnt(" #n ")" ::: "memory")
#define PG8_BAR __builtin_amdgcn_s_barrier()
#define PG8_SCHED __builtin_amdgcn_sched_barrier(0)
    Unit cur, nxt; int ui = 0;
    if (!S.next(0, cur)) return;
    f32x4 acc[2][2][4][2];
#pragma unroll
    for (int a = 0; a < 2; ++a)
#pragma unroll
        for (int b = 0; b < 2; ++b)
#pragma unroll
            for (int m = 0; m < 4; ++m)
#pragma unroll
                for (int n = 0; n < 2; ++n) acc[a][b][m][n] = (f32x4){0.f, 0.f, 0.f, 0.f};
    bf16x8 At[4][2], B0[2][2], B1[2][2];
    const char* cA = (const char*)g.A + (size_t)cur.pm * tstep + (size_t)cur.kofs * 2; const char* cB = (const char*)g.Bt + (size_t)cur.pn * tstep + (size_t)cur.kofs * 2;
    if constexpr (SP2) {
        PG8_STAGE(PG8_SB(0, 0), cB, voffB); PG8_STAGE(PG8_SB(0, 1), cB + hstep, voffB); PG8_STAGE(PG8_SA(0, 0), cA, voffA); PG8_STAGE(PG8_SA(0, 1), cA + hstep, voffA);
        if (wr == 1) PG8_BAR;
        PG8_WAIT_V(2); PG8_BAR;
        PG8_STAGE(PG8_SB(1, 0), cB + kstep, voffB); PG8_STAGE(PG8_SA(1, 0), cA + kstep, voffA); PG8_STAGE(PG8_SB(1, 1), cB + hstep + kstep, voffB);
        PG8_WAIT_V(6); PG8_BAR;
    } else {
        PG8_STAGE(PG8_SB(0, 0), cB, voffB); PG8_STAGE(PG8_SA(0, 0), cA, voffA); PG8_STAGE(PG8_SB(0, 1), cB + hstep, voffB); PG8_STAGE(PG8_SA(0, 1), cA + hstep, voffA);
        if (wr == 1) PG8_BAR;
        PG8_WAIT_V(4); PG8_BAR;
        PG8_STAGE(PG8_SB(1, 0), cB + kstep, voffB); PG8_STAGE(PG8_SA(1, 0), cA + kstep, voffA); PG8_STAGE(PG8_SB(1, 1), cB + hstep + kstep, voffB);
        PG8_WAIT_V(6); PG8_BAR;
    }
    for (;;) {
        const bool has_next = S.next(ui + 1, nxt);
        const char* nA = has_next ? (const char*)g.A + (size_t)nxt.pm * tstep + (size_t)nxt.kofs * 2 : cA; const char* nB = has_next ? (const char*)g.Bt + (size_t)nxt.pn * tstep + (size_t)nxt.kofs * 2 : cB;
        const int nt = cur.nt;
        for (int t = 0; t < nt; t += 2) {
            const bool last = (t == nt - 2);
            const char* a1 = cA + (size_t)(t + 1) * kstep;
            const char* a2 = last ? nA : cA + (size_t)(t + 2) * kstep; const char* b2 = last ? nB : cB + (size_t)(t + 2) * kstep;
            const char* a3 = a2 + kstep; const char* b3 = b2 + kstep;
            if constexpr (SP2) {
            const int fresh = __builtin_amdgcn_readfirstlane(((Epi::MIN_VM > 0) && (t == 0) && (ui > 0)) ? 1 : 0);
            PG8_LDB(B0, 0, 0); PG8_LDB(B1, 0, 1); PG8_SCHED; PG8_LDA(At, 0, 0); PG8_STAGE(PG8_SA(1, 1), a1 + hstep, voffA);
            PG8_WAIT_VF(26, 18); PG8_WAIT_L(0); PG8_BAR; PG8_MMA(0, 0, At, B0); PG8_MMA(0, 1, At, B1); PG8_BAR; PG8_SCHED;
            PG8_LDA(At, 0, 1); PG8_STAGE(PG8_SB(0, 0), b2, voffB); PG8_STAGE(PG8_SB(0, 1), b2 + hstep, voffB); PG8_STAGE(PG8_SA(0, 0), a2, voffA);
            PG8_WAIT_VF(26, 18); PG8_WAIT_L(0); PG8_BAR; PG8_MMA(1, 0, At, B0); PG8_MMA(1, 1, At, B1); PG8_BAR; PG8_SCHED;
            PG8_LDB(B0, 1, 0); PG8_LDB(B1, 1, 1); PG8_SCHED; PG8_LDA(At, 1, 0); PG8_STAGE(PG8_SA(0, 1), a2 + hstep, voffA);
            PG8_WAIT_VF(26, 18); PG8_WAIT_L(0); PG8_BAR; PG8_MMA(0, 0, At, B0); PG8_MMA(0, 1, At, B1); PG8_BAR; PG8_SCHED;
            PG8_LDA(At, 1, 1); PG8_STAGE(PG8_SB(1, 0), b3, voffB); PG8_STAGE(PG8_SB(1, 1), b3 + hstep, voffB); PG8_STAGE(PG8_SA(1, 0), a3, voffA);
            PG8_WAIT_VF(32, 24); PG8_WAIT_L(0); PG8_BAR; PG8_MMA(1, 0, At, B0); PG8_MMA(1, 1, At, B1); PG8_BAR; PG8_SCHED;
            } else {
            PG8_LDB(B0, 0, 0); PG8_SCHED; PG8_LDA(At, 0, 0); PG8_STAGE(PG8_SA(1, 1), a1 + hstep, voffA);
            PG8_WAIT_L(8); PG8_BAR; PG8_WAIT_L(0); PG8_MMA(0, 0, At, B0); PG8_BAR; PG8_SCHED;
            PG8_LDB(B1, 0, 1); PG8_STAGE(PG8_SB(0, 0), b2, voffB);
            PG8_BAR; PG8_WAIT_L(0); PG8_MMA(0, 1, At, B1); PG8_BAR;
            PG8_LDA(At, 0, 1); PG8_STAGE(PG8_SA(0, 0), a2, voffA);
            PG8_BAR; PG8_WAIT_L(0); PG8_MMA(1, 0, At, B0); PG8_BAR; PG8_SCHED;
            PG8_STAGE(PG8_SB(0, 1), b2 + hstep, voffB);
            PG8_WAIT_V(6); PG8_BAR; PG8_MMA(1, 1, At, B1); PG8_BAR;
            PG8_LDB(B0, 1, 0); PG8_SCHED; PG8_LDA(At, 1, 0); PG8_STAGE(PG8_SA(0, 1), a2 + hstep, voffA);
            PG8_WAIT_L(8); PG8_BAR; PG8_WAIT_L(0); PG8_MMA(0, 0, At, B0); PG8_BAR; PG8_SCHED;
            PG8_LDB(B1, 1, 1); PG8_STAGE(PG8_SB(1, 0), b3, voffB);
            PG8_BAR; PG8_WAIT_L(0); PG8_MMA(0, 1, At, B1); PG8_BAR;
            PG8_LDA(At, 1, 1); PG8_STAGE(PG8_SA(1, 0), a3, voffA);
            PG8_BAR; PG8_WAIT_L(0); PG8_MMA(1, 0, At, B0); PG8_BAR; PG8_SCHED;
            PG8_STAGE(PG8_SB(1, 1), b3 + hstep, voffB);
            PG8_WAIT_V(6); PG8_BAR; PG8_MMA(1, 1, At, B1); PG8_BAR;
            }
        }
        if constexpr (SP2 && Epi::MIN_VM > 0) { if (has_next) PG8_STAGE(PG8_SA(1, 1), nA + kstep + hstep, voffA); }
        if constexpr (ALIGN_EPI) { if (wr == 0) PG8_BAR; }
        E(acc, cur, wr, wc, fr, fq);
        if (!has_next) break;
#pragma unroll
        for (int a = 0; a < 2; ++a)
#pragma unroll
            for (int b = 0; b < 2; ++b)
#pragma unroll
                for (int m = 0; m < 4; ++m)
#pragma unroll
                    for (int n = 0; n < 2; ++n) acc[a][b][m][n] = (f32x4){0.f, 0.f, 0.f, 0.f};
        cur = nxt; cA = nA; cB = nB; ++ui;
        if constexpr (ALIGN_EPI) { if (wr == 1) PG8_BAR; }
    }
    PG8_WAIT_V(0);
    if constexpr (!ALIGN_EPI) { if (wr == 0) PG8_BAR; }
    PG8_BAR;
#undef PG8_SA
#undef PG8_SB
#undef PG8_STAGE
#undef PG8_LDA
#undef PG8_LDB
#undef PG8_MMA
#undef PG8_WAIT_V
#undef PG8_WAIT_VF
#undef PG8_WAIT_VF_
#undef PG8_WAIT_L
#undef PG8_BAR
#undef PG8_SCHED
}
}

enum { ORD_RW0 = 0, ORD_RW1, ORD_L20, ORD_L21, ORD_N8, ORD_N24, ORD_N12, ORD_N44, ORD_N };
#define SUBS1(n) {1, 34 * (n), 0, 0, {{(n), 0, 0, 0}, {0,0,0,0},{0,0,0,0},{0,0,0,0},{0,0,0,0},{0,0,0,0},{0,0,0,0},{0,0,0,0}}}
__constant__ pg8::OrdTab g_ord[ORD_N] = {
    {6, 34 * 27, 0, 0, {{8, 0, 0, 0}, {8, 34, 8, 34 * 8}, {8, 68, 16, 34 * 16}, {1, 102, 24, 34 * 24}, {1, 136, 25, 34 * 25}, {1, 170, 26, 34 * 26}, {0,0,0,0}, {0,0,0,0}}},
    {7, 34 * 28, 0, 0, {{8, 0, 0, 0}, {8, 34, 8, 34 * 8}, {8, 68, 16, 34 * 16}, {1, 102, 24, 34 * 24}, {1, 136, 25, 34 * 25}, {1, 170, 26, 34 * 26}, {1, 68, 27, 34 * 27}, {0,0,0,0}}},
    {3, 34 * 40, 1, 0, {{16, 0, 0, 0}, {16, 34, 16, 34 * 16}, {8, 68, 32, 34 * 32}, {0,0,0,0},{0,0,0,0},{0,0,0,0},{0,0,0,0},{0,0,0,0}}},
    {4, 34 * 48, 1, 0, {{16, 0, 0, 0}, {16, 34, 16, 34 * 16}, {8, 68, 32, 34 * 32}, {8, 102, 40, 34 * 40}, {0,0,0,0},{0,0,0,0},{0,0,0,0},{0,0,0,0}}},
    SUBS1(8), SUBS1(24), SUBS1(12), SUBS1(44)
};
struct OutDesc { unsigned long long off; int ldc, mode, nsplit; unsigned long long split_stride; int bias_in, bias_off; };
enum { OD_RW0 = 0, OD_RW1, OD_L20, OD_L21, OD_NAQKV, OD_GAQKV, OD_UP, OD_N };
#define ODZ {0, 0, 0, 1, 0, -1, 0}
__constant__ OutDesc g_od[OD_N][8] = {
    { {WS_RKV, 2048, 0, 1 << 20, 0, -1, 0}, {WS_RKV + SZ_ACT, 2048, 0, 1 << 20, 0, -1, 0}, {WS_V0, 2048, 0, 1 << 20, 0, -1, 0},
      {WS_L1O, 256, 1, 1 << 20, 0, -1, 0}, {WS_L1O + (size_t)M * 512, 256, 0, 1 << 20, 0, -1, 0}, {WS_L1O + (size_t)M * 1024, 256, 2, 1 << 20, 0, -1, 0}, ODZ, ODZ },
    { {WS_RKV, 2048, 0, 1 << 20, 0, -1, 0}, {WS_RKV + SZ_ACT, 2048, 0, 1 << 20, 0, -1, 0}, {WS_RKV + 2 * SZ_ACT, 2048, 0, 1 << 20, 0, -1, 0},
      {WS_L1O, 256, 1, 1 << 20, 0, -1, 0}, {WS_L1O + (size_t)M * 512, 256, 0, 1 << 20, 0, -1, 0}, {WS_L1O + (size_t)M * 1024, 256, 2, 1 << 20, 0, -1, 0},
      {WS_L1O + (size_t)M * 1536, 256, 0, 1 << 20, 0, -1, 0}, ODZ },
    { {WS_DEC, 2048, 4, 8, (unsigned long long)M * 2048, 14, 0}, {WS_AA, 2048, 3, 8, (unsigned long long)M * 2048, 17, 0}, {WS_GG, 2048, 0, 1 << 20, 0, -1, 0}, ODZ, ODZ, ODZ, ODZ, ODZ },
    { {WS_DEC, 2048, 4, 8, (unsigned long long)M * 2048, 14, 4096}, {WS_AA, 2048, 3, 8, (unsigned long long)M * 2048, 17, 4096}, {WS_GG, 2048, 0, 1 << 20, 0, -1, 0},
      {WS_VG, 2048, 3, 1 << 20, 0, 28, 0}, ODZ, ODZ, ODZ, ODZ },
    { {WS_QKV, 6144, 0, 1 << 20, 0, -1, 0}, ODZ, ODZ, ODZ, ODZ, ODZ, ODZ, ODZ },
    { {WS_QKV, 3072, 0, 1 << 20, 0, -1, 0}, ODZ, ODZ, ODZ, ODZ, ODZ, ODZ, ODZ },
    { {WS_QKV, 11264, 0, 1 << 20, 0, -1, 0}, ODZ, ODZ, ODZ, ODZ, ODZ, ODZ, ODZ },
};

struct Args { const float* in[40]; float* out; unsigned char* ws; int ph_lo, ph_hi; };

struct EpiGen {
    static constexpr bool PERM = true; static constexpr int MIN_VM = 16;
    unsigned char* ws; const OutDesc* od; const float* const* in;
    __device__ __forceinline__ void operator()(const f32x4 (&acc)[2][2][4][2], const pg8::Unit& u, int wr, int wc, int fr, int fq) const {
        const OutDesc* d = od + u.sub;
        const int ldc = d->ldc, mode = d->mode, nsplit = d->nsplit;
        const int sp = u.ln / nsplit, lnl = u.ln - sp * nsplit;
        const int row0 = u.lm * 256 + wr * 64 + fr, col0 = lnl * 256 + wc * 32 + 8 * fq, bcol0 = u.ln * 256 + wc * 32 + 8 * fq;
        unsigned char* base = ws + d->off;
        const size_t esplit = (size_t)sp * d->split_stride;
        const float* bias = (d->bias_in >= 0) ? (in[d->bias_in] + d->bias_off) : nullptr;
        f32x4 bv[2][2];
#pragma unroll
        for (int bj = 0; bj < 2; ++bj)
#pragma unroll
            for (int n = 0; n < 2; ++n) bv[bj][n] = bias ? *(const f32x4*)(bias + bcol0 + bj * 128 + 4 * n) : (f32x4){0.f, 0.f, 0.f, 0.f};
#pragma unroll
        for (int ai = 0; ai < 2; ++ai)
#pragma unroll
            for (int m = 0; m < 4; ++m) {
                const size_t eoff = esplit + (size_t)(row0 + ai * 128 + m * 16) * ldc + col0;
#pragma unroll
                for (int bj = 0; bj < 2; ++bj) {
                    f32x4 v0 = acc[ai][bj][m][0] + bv[bj][0], v1 = acc[ai][bj][m][1] + bv[bj][1];
                    if (mode == 1) {
#pragma unroll
                        for (int j = 0; j < 4; ++j) { v0[j] = 1.f - 2.f * __builtin_amdgcn_rcpf(1.f + __expf(2.f * v0[j])); v1[j] = 1.f - 2.f * __builtin_amdgcn_rcpf(1.f + __expf(2.f * v1[j])); }
                    } else if (mode == 2 || mode == 3) {
#pragma unroll
                        for (int j = 0; j < 4; ++j) { v0[j] = sigmoidf_(v0[j]); v1[j] = sigmoidf_(v1[j]); }
                    } else if (mode == 4) {
#pragma unroll
                        for (int j = 0; j < 4; ++j) { v0[j] = __expf(-0.6065306597f * sigmoidf_(v0[j])); v1[j] = __expf(-0.6065306597f * sigmoidf_(v1[j])); }
                    }
                    if (mode == 4) {
                        typedef _Float16 h2 __attribute__((ext_vector_type(2)));
                        pg8::u32x4 w;
                        w.x = __builtin_bit_cast(unsigned, (h2){(_Float16)(1.f - v0[0]), (_Float16)(1.f - v0[1])}); w.y = __builtin_bit_cast(unsigned, (h2){(_Float16)(1.f - v0[2]), (_Float16)(1.f - v0[3])});
                        w.z = __builtin_bit_cast(unsigned, (h2){(_Float16)(1.f - v1[0]), (_Float16)(1.f - v1[1])}); w.w = __builtin_bit_cast(unsigned, (h2){(_Float16)(1.f - v1[2]), (_Float16)(1.f - v1[3])});
                        *(pg8::u32x4*)((bf16*)base + eoff + bj * 128) = w;
                    } else {
                        pg8::u32x4 w; w.x = cvt_pk_bf16(v0[0], v0[1]); w.y = cvt_pk_bf16(v0[2], v0[3]); w.z = cvt_pk_bf16(v1[0], v1[1]); w.w = cvt_pk_bf16(v1[2], v1[3]);
                        *(pg8::u32x4*)((bf16*)base + eoff + bj * 128) = w;
                    }
                }
            }
    }
};
struct EpiRes {
    static constexpr bool PERM = true; static constexpr int MIN_VM = 16;
    bf16* X; const float* gate3; float* outp; float* part; const float* xin;
    __device__ __forceinline__ void operator()(const f32x4 (&acc)[2][2][4][2], const pg8::Unit& u, int wr, int wc, int fr, int fq) const {
        const int b = u.lm / 17, tb = u.lm - b * 17; const int isctx = (tb == 16);
        const float* gate = gate3 + (size_t)(isctx ? 2 : b) * (6 * D);
        const int row0 = u.lm * 256 + wr * 64 + fr, col0 = u.ln * 256 + wc * 32 + 8 * fq;
        if (u.kpart >= 0) {
            float* pb = part + ((size_t)u.kpart * 512 + (size_t)b * 256 + wr * 64 + fr) * D + col0;
#pragma unroll
            for (int ai = 0; ai < 2; ++ai)
#pragma unroll
                for (int m = 0; m < 4; ++m)
#pragma unroll
                    for (int bj = 0; bj < 2; ++bj) { float* p = pb + (size_t)(ai * 128 + m * 16) * D + bj * 128; *(f32x4*)p = acc[ai][bj][m][0]; *(f32x4*)(p + 4) = acc[ai][bj][m][1]; }
            return;
        }
        if (outp && isctx) { asm volatile("s_waitcnt vmcnt(0)" ::: "memory"); return; }
        const long radj = (long)(b * 16 + tb) * 256 - (long)u.lm * 256;
        f32x4 gv[2][2];
#pragma unroll
        for (int bj = 0; bj < 2; ++bj)
#pragma unroll
            for (int n = 0; n < 2; ++n) gv[bj][n] = *(const f32x4*)(gate + col0 + bj * 128 + 4 * n);
#pragma unroll
        for (int ai = 0; ai < 2; ++ai)
#pragma unroll
            for (int m = 0; m < 4; ++m) {
                const int row = row0 + ai * 128 + m * 16;
                bf16* xb = X + (size_t)row * D + col0;
#pragma unroll
                for (int bj = 0; bj < 2; ++bj) {
                    f32x4 x0, x1;
                    if (xin) { const float* xp = xin + (size_t)(row + radj) * D + col0 + bj * 128; x0 = *(const f32x4*)xp; x1 = *(const f32x4*)(xp + 4); }
                    else { const pg8::u32x4 t = *(const pg8::u32x4*)(xb + bj * 128); x0 = (f32x4){bflo(t.x), bfhi(t.x), bflo(t.y), bfhi(t.y)}; x1 = (f32x4){bflo(t.z), bfhi(t.z), bflo(t.w), bfhi(t.w)}; }
                    const f32x4 y0 = x0 + gv[bj][0] * acc[ai][bj][m][0], y1 = x1 + gv[bj][1] * acc[ai][bj][m][1];
                    if (outp) { float* op = outp + (size_t)(row + radj) * D + col0 + bj * 128; *(f32x4*)op = y0; *(f32x4*)(op + 4) = y1; }
                    else { pg8::u32x4 w; w.x = cvt_pk_bf16(y0.x, y0.y); w.y = cvt_pk_bf16(y0.z, y0.w); w.z = cvt_pk_bf16(y1.x, y1.y); w.w = cvt_pk_bf16(y1.z, y1.w); *(pg8::u32x4*)(xb + bj * 128) = w; }
                }
            }
    }
};


struct EpiQKV {
    static constexpr bool PERM = true; static constexpr int MIN_VM = 16;
    bf16* O; int ldc, nqk, nq; const float* qg; const float* kg; int rope; LAS float* part;
    __device__ __forceinline__ void operator()(const f32x4 (&acc)[2][2][4][2], const pg8::Unit& u, int wr, int wc, int fr_in, int fq_in) const {
        int fr = fr_in, fq = fq_in; asm volatile("" : "+v"(fr), "+v"(fq));
        const bool isqk = u.ln < nqk;
        if (isqk) {
#pragma unroll
            for (int ai = 0; ai < 2; ++ai)
#pragma unroll
                for (int m = 0; m < 4; ++m)
#pragma unroll
                    for (int bj = 0; bj < 2; ++bj) {
                        const f32x4 a = acc[ai][bj][m][0], b = acc[ai][bj][m][1];
                        float s = ((a.x * a.x + a.y * a.y) + (a.z * a.z + a.w * a.w)) + ((b.x * b.x + b.y * b.y) + (b.z * b.z + b.w * b.w));
                        { const auto x = __builtin_amdgcn_permlane16_swap(__float_as_uint(s), __float_as_uint(s), false, false); s = __uint_as_float(x[0]) + __uint_as_float(x[1]); }
                        { const auto x = __builtin_amdgcn_permlane32_swap(__float_as_uint(s), __float_as_uint(s), false, false); s = __uint_as_float(x[0]) + __uint_as_float(x[1]); }
                        if (fq == 0) part[((ai * 128 + wr * 64 + m * 16 + fr) * 2 + bj) * 4 + wc] = s;
                    }
        }
        asm volatile("s_waitcnt lgkmcnt(0)" ::: "memory"); __builtin_amdgcn_s_barrier(); asm volatile("" ::: "memory");
        const float* g = (u.ln < nq) ? qg : kg;
        const int cc0 = 32 * (wc & 1) + 8 * fq;
        const float* gA = rope ? (g + 64 * (wc >> 1) + (cc0 >> 1)) : (g + 32 * wc + 8 * fq);
        const float* gB = rope ? (gA + 32) : (gA + 4);
#pragma unroll
        for (int ai = 0; ai < 2; ++ai)
#pragma unroll
            for (int m = 0; m < 4; ++m) {
                const int rl = ai * 128 + wr * 64 + m * 16 + fr, row = u.lm * 256 + rl;
                const int tb = row % SB; const bool lat = tb < SEQ;
                const float ps = (float)((wc >> 1) ? (tb & 63) : (tb >> 6));
#pragma unroll
                for (int bj = 0; bj < 2; ++bj) {
                    float x[8]; { const f32x4 t0 = acc[ai][bj][m][0], t1 = acc[ai][bj][m][1]; x[0] = t0.x; x[1] = t0.y; x[2] = t0.z; x[3] = t0.w; x[4] = t1.x; x[5] = t1.y; x[6] = t1.z; x[7] = t1.w; }
                    if (isqk) {
                        const f32x4 p4 = *(const LAS f32x4*)(part + (rl * 2 + bj) * 4);
                        const float rstd = rsqrtf(((p4.x + p4.y) + (p4.z + p4.w)) * (1.f / 128.f) + NORM_EPS);
                        const f32x4 ga = *(const f32x4*)gA, gb = *(const f32x4*)gB;
                        if (rope) { x[0] *= rstd * ga.x; x[1] *= rstd * gb.x; x[2] *= rstd * ga.y; x[3] *= rstd * gb.y; x[4] *= rstd * ga.z; x[5] *= rstd * gb.z; x[6] *= rstd * ga.w; x[7] *= rstd * gb.w; }
                        else { x[0] *= rstd * ga.x; x[1] *= rstd * ga.y; x[2] *= rstd * ga.z; x[3] *= rstd * ga.w; x[4] *= rstd * gb.x; x[5] *= rstd * gb.y; x[6] *= rstd * gb.z; x[7] *= rstd * gb.w; }
                        if (rope && lat) {
#pragma unroll
                            for (int pq = 0; pq < 4; ++pq) { const float ang = ps * __builtin_amdgcn_exp2f(-(float)((cc0 >> 1) + pq) * (13.287712379549449f / 32.f)), cs = __cosf(ang), sn = __sinf(ang), x1 = x[2 * pq], x2 = x[2 * pq + 1];
                                x[2 * pq] = x1 * cs - x2 * sn; x[2 * pq + 1] = x1 * sn + x2 * cs; }
                        }
                    }
                    pg8::u32x4 w; w.x = cvt_pk_bf16_v(x[0], x[1]); w.y = cvt_pk_bf16_v(x[2], x[3]); w.z = cvt_pk_bf16_v(x[4], x[5]); w.w = cvt_pk_bf16_v(x[6], x[7]);
                    *(pg8::u32x4*)(O + (size_t)row * ldc + u.ln * 256 + bj * 128 + wc * 32 + 8 * fq) = w;
                }
                asm volatile("" ::: "memory");
            }
    }
};

template <int CTRL, bool BC> __device__ __forceinline__ float dppu(float old, float v) { return __builtin_bit_cast(float, __builtin_amdgcn_update_dpp(__builtin_bit_cast(int, old), __builtin_bit_cast(int, v), CTRL, 0xF, 0xF, BC)); }
struct EpiUp {
    static constexpr bool PERM = true; static constexpr int MIN_VM = 8;
    bf16* ACT; float* HALO; const float* cw; const float* cb;
    __device__ __forceinline__ void operator()(const f32x4 (&acc)[2][2][4][2], const pg8::Unit& u, int wr, int wc, int fr, int fq) const {
        const int f0 = u.ln * 128 + wc * 32 + 8 * fq;
#pragma unroll
        for (int ai = 0; ai < 2; ++ai) {
            const int rowbase = u.lm * 256 + ai * 128 + wr * 64, grp = rowbase >> 6;
            if (fr < 2 || fr >= 14) {
                const int m = fr < 2 ? 0 : 3; float* hp = HALO + (size_t)(grp * 4 + (fr < 2 ? fr : fr - 12)) * DFF2 + f0;
#pragma unroll
                for (int bj = 0; bj < 2; ++bj)
#pragma unroll
                    for (int n = 0; n < 2; ++n) *(f32x4*)(hp + bj * DFF + 4 * n) = fr < 2 ? acc[ai][bj][0][n] : acc[ai][bj][3][n];
                (void)m;
            }
            unsigned ow[4][4];
#pragma unroll
            for (int n = 0; n < 2; ++n) {
                const int fc = f0 + 4 * n;
                const f32x4 g0 = *(const f32x4*)(cw + fc), g1 = *(const f32x4*)(cw + DFF2 + fc), g2 = *(const f32x4*)(cw + 2 * DFF2 + fc), gb = *(const f32x4*)(cb + fc);
                const f32x4 v0 = *(const f32x4*)(cw + DFF + fc), v1 = *(const f32x4*)(cw + DFF2 + DFF + fc), v2 = *(const f32x4*)(cw + 2 * DFF2 + DFF + fc), vb = *(const f32x4*)(cb + DFF + fc);
                float o[4][4];
#pragma unroll
                for (int e = 0; e < 4; ++e) {
                    float G[4], V[4];
#pragma unroll
                    for (int m = 0; m < 4; ++m) {
                        {   const float c = acc[ai][0][m][n][e];
                            const float pv = (m > 0) ? dppu<0x111, false>(dppu<0x121, true>(0.f, acc[ai][0][m > 0 ? m - 1 : 0][n][e]), c) : dppu<0x111, true>(0.f, c);
                            const float nx = (m < 3) ? dppu<0x101, false>(dppu<0x12F, true>(0.f, acc[ai][0][m < 3 ? m + 1 : 3][n][e]), c) : dppu<0x101, true>(0.f, c);
                            G[m] = gb[e] + g0[e] * pv + g1[e] * c + g2[e] * nx; }
                        {   const float c = acc[ai][1][m][n][e];
                            const float pv = (m > 0) ? dppu<0x111, false>(dppu<0x121, true>(0.f, acc[ai][1][m > 0 ? m - 1 : 0][n][e]), c) : dppu<0x111, true>(0.f, c);
                            const float nx = (m < 3) ? dppu<0x101, false>(dppu<0x12F, true>(0.f, acc[ai][1][m < 3 ? m + 1 : 3][n][e]), c) : dppu<0x101, true>(0.f, c);
                            V[m] = vb[e] + v0[e] * pv + v1[e] * c + v2[e] * nx; }
                        o[m][e] = G[m] * V[m] * __builtin_amdgcn_rcpf(1.f + __expf(-G[m]));
                    }
                }
#pragma unroll
                for (int m = 0; m < 4; ++m) { ow[m][2 * n] = cvt_pk_bf16(o[m][0], o[m][1]); ow[m][2 * n + 1] = cvt_pk_bf16(o[m][2], o[m][3]); }
            }
#pragma unroll
            for (int m = 0; m < 4; ++m) { v4u w; w.x = ow[m][0]; w.y = ow[m][1]; w.z = ow[m][2]; w.w = ow[m][3];
                *(v4u*)(ACT + (size_t)(rowbase + 16 * m + fr) * DFF + f0) = w; }
        }
    }
};

namespace att {
using s16x4  = __attribute__((ext_vector_type(4))) short;
using f32x16 = __attribute__((ext_vector_type(16))) float;
using u32x4  = __attribute__((ext_vector_type(4))) unsigned;
constexpr int KVBLK = 64, QBLK = 32, NW = 8;
constexpr float SCALE = 0.088388347648318440f;
constexpr float THR = 8.f;
constexpr float NEGBIG = -1e30f;
constexpr size_t SHM_V = KVBLK * HD * 2, SHM_K = KVBLK * HD * 2, SHM_ATTN = 2 * SHM_V + 2 * SHM_K + NW * 64 * 4;
#define KSWZ(row, colB) ((row) * 256 + ((colB) ^ (((row) & 7) << 4)))
#define SBAR() __builtin_amdgcn_sched_barrier(0)
__device__ __forceinline__ int crow(int r, int hi) { return (r & 3) + 8 * (r >> 2) + 4 * hi; }
__device__ __forceinline__ unsigned cvtpk(float lo, float hi) { unsigned r; asm volatile("v_cvt_pk_bf16_f32 %0, %1, %2" : "=v"(r) : "v"(lo), "v"(hi)); return r; }

template <bool FIXM = false>
__device__ __forceinline__ void partialSM(f32x16& p0, f32x16& p1, float& m_reg, float& mn, float& alpha) {
  constexpr float C = SCALE * 1.4426950408889634f;
  if constexpr (FIXM) { mn = m_reg; alpha = 1.f; return; }
  float pmax = p0[0]; for (int r = 1; r < 16; ++r) pmax = fmaxf(pmax, p0[r]); for (int r = 0; r < 16; ++r) pmax = fmaxf(pmax, p1[r]);
  { auto rr = __builtin_amdgcn_permlane32_swap(__float_as_uint(pmax), __float_as_uint(pmax), false, false);
    pmax = fmaxf(__uint_as_float(rr[0]), __uint_as_float(rr[1])); }
  if (__builtin_expect(__all(pmax - m_reg <= THR / SCALE), 1)) { mn = m_reg; alpha = 1.f; }
  else { mn = fmaxf(m_reg, pmax); alpha = __builtin_amdgcn_exp2f((m_reg - mn) * C); m_reg = mn; }
  float mnC = -mn * C;
  for (int r = 0; r < 16; ++r) p0[r] = fmaf(p0[r], C, mnC); for (int r = 0; r < 16; ++r) p1[r] = fmaf(p1[r], C, mnC);
  for (int r = 0; r < 16; ++r) p0[r] = __builtin_amdgcn_exp2f(p0[r]);
}
template <bool FIXM = false>
__device__ __forceinline__ void finishSM(f32x16& p0, f32x16& p1, float alpha, float& l_reg, bf16x8& pa0, bf16x8& pa1, bf16x8& pa2, bf16x8& pa3, float mfix = 0.f) {
  if constexpr (FIXM) { constexpr float C = SCALE * 1.4426950408889634f; const float mnC_ = -mfix * C;
    for (int r = 0; r < 16; ++r) p0[r] = __builtin_amdgcn_exp2f(fmaf(p0[r], C, mnC_)); for (int r = 0; r < 16; ++r) p1[r] = __builtin_amdgcn_exp2f(fmaf(p1[r], C, mnC_)); }
  else for (int r = 0; r < 16; ++r) p1[r] = __builtin_amdgcn_exp2f(p1[r]);
  float ps = 0; for (int r = 0; r < 16; ++r) ps += p0[r]; for (int r = 0; r < 16; ++r) ps += p1[r];
  { auto rr = __builtin_amdgcn_permlane32_swap(__float_as_uint(ps), __float_as_uint(ps), false, false);
    ps = __uint_as_float(rr[0]) + __uint_as_float(rr[1]); }
  l_reg = l_reg * alpha + ps;
#define PK4(P, BASE, OUT) do { unsigned a0 = cvtpk(P[BASE + 0], P[BASE + 1]), a1 = cvtpk(P[BASE + 2], P[BASE + 3]);   \
    unsigned b0 = cvtpk(P[BASE + 4], P[BASE + 5]), b1 = cvtpk(P[BASE + 6], P[BASE + 7]);                              \
    auto r0 = __builtin_amdgcn_permlane32_swap(a0, b0, false, false); auto r1 = __builtin_amdgcn_permlane32_swap(a1, b1, false, false); \
    u32x4 w = {r0[0], r1[0], r0[1], r1[1]}; OUT = *reinterpret_cast<bf16x8*>(&w); } while (0)
  PK4(p0, 0, pa0); PK4(p0, 8, pa1); PK4(p1, 0, pa2); PK4(p1, 8, pa3);
#undef PK4
}
template <unsigned M0, unsigned M1, bool FIXM = false>
__device__ __forceinline__ void partialSM_m(f32x16& p0, f32x16& p1, float& m_reg, float& mn, float& alpha) {
  constexpr float C = SCALE * 1.4426950408889634f;
  if constexpr (FIXM) {
    mn = m_reg; alpha = 1.f; const float mnC_ = -mn * C;
#pragma unroll
    for (int r = 0; r < 16; ++r) { p0[r] = ((M0 >> r) & 1u) ? __builtin_amdgcn_exp2f(fmaf(p0[r], C, mnC_)) : 0.f; p1[r] = ((M1 >> r) & 1u) ? fmaf(p1[r], C, mnC_) : 0.f; }
    return;
  }
  float pmax = NEGBIG;
#pragma unroll
  for (int r = 0; r < 16; ++r) { pmax = fmaxf(pmax, ((M0 >> r) & 1u) ? p0[r] : NEGBIG); pmax = fmaxf(pmax, ((M1 >> r) & 1u) ? p1[r] : NEGBIG); }
  { auto rr = __builtin_amdgcn_permlane32_swap(__float_as_uint(pmax), __float_as_uint(pmax), false, false);
    pmax = fmaxf(__uint_as_float(rr[0]), __uint_as_float(rr[1])); }
  if (__builtin_expect(__all(pmax - m_reg <= THR / SCALE), 1)) { mn = m_reg; alpha = 1.f; }
  else { mn = fmaxf(m_reg, pmax); alpha = __builtin_amdgcn_exp2f((m_reg - mn) * C); m_reg = mn; }
  const float mnC = -mn * C;
#pragma unroll
  for (int r = 0; r < 16; ++r) { p0[r] = ((M0 >> r) & 1u) ? __builtin_amdgcn_exp2f(fmaf(p0[r], C, mnC)) : 0.f; p1[r] = ((M1 >> r) & 1u) ? fmaf(p1[r], C, mnC) : 0.f; }
}
template <unsigned M0, unsigned M1>
__device__ __forceinline__ void finishSM_m(f32x16& p0, f32x16& p1, float alpha, float& l_reg, bf16x8& pa0, bf16x8& pa1, bf16x8& pa2, bf16x8& pa3) {
  float ps = 0;
#pragma unroll
  for (int r = 0; r < 16; ++r) { p1[r] = ((M1 >> r) & 1u) ? __builtin_amdgcn_exp2f(p1[r]) : 0.f; ps += p1[r]; ps += p0[r]; }
  { auto rr = __builtin_amdgcn_permlane32_swap(__float_as_uint(ps), __float_as_uint(ps), false, false);
    ps = __uint_as_float(rr[0]) + __uint_as_float(rr[1]); }
  l_reg = l_reg * alpha + ps;
#define PK4(P, BASE, OUT) do { unsigned a0 = cvtpk(P[BASE + 0], P[BASE + 1]), a1 = cvtpk(P[BASE + 2], P[BASE + 3]);   \
    unsigned b0 = cvtpk(P[BASE + 4], P[BASE + 5]), b1 = cvtpk(P[BASE + 6], P[BASE + 7]);                              \
    auto r0 = __builtin_amdgcn_permlane32_swap(a0, b0, false, false); auto r1 = __builtin_amdgcn_permlane32_swap(a1, b1, false, false); \
    u32x4 w = {r0[0], r1[0], r0[1], r1[1]}; OUT = *reinterpret_cast<bf16x8*>(&w); } while (0)
  PK4(p0, 0, pa0); PK4(p0, 8, pa1); PK4(p1, 0, pa2); PK4(p1, 8, pa3);
#undef PK4
}
__device__ __forceinline__ void qkt(f32x16& p0, f32x16& p1, const bf16* Ks, const bf16x8* qr, int r32, int hi) {
  p0 = f32x16{}; p1 = f32x16{};
  for (int d0 = 0; d0 < 8; ++d0) { int cb = (d0 * 16 + hi * 8) * 2;
    bf16x8 b0 = *reinterpret_cast<const bf16x8*>((const char*)Ks + KSWZ(r32, cb));
    bf16x8 b1 = *reinterpret_cast<const bf16x8*>((const char*)Ks + KSWZ(32 + r32, cb));
    p0 = __builtin_amdgcn_mfma_f32_32x32x16_bf16(b0, qr[d0], p0, 0, 0, 0);
    p1 = __builtin_amdgcn_mfma_f32_32x32x16_bf16(b1, qr[d0], p1, 0, 0, 0); }
}
__device__ __forceinline__ int v_st(int k, int c) { const int kk = (k & ~0xC) | ((k & 4) << 1) | ((k & 8) >> 1); return ((kk >> 3) * 4 + (c >> 5)) * 512 + ((kk & 7) * 32 + (c & 31)) * 2; }
__device__ __forceinline__ int v_rd_base(int lane) { return ((lane & 3) << 3) | (((lane >> 2) & 3) << 6) | (((lane >> 4) & 1) << 5) | (((lane >> 5) & 1) << 8); }
constexpr int v_rd_off(int d0, int ks, int half) { return d0 * 512 + ks * 4096 + half * 2048; }
template <int OFF> __device__ __forceinline__ s16x4 tr_read(int vb) {
  s16x4 r; asm volatile("ds_read_b64_tr_b16 %0, %1 offset:%2" : "=&v"(r) : "v"(vb), "i"(OFF) : "memory"); return r;
}
template <int D0, int SKIP = 0> __device__ __forceinline__ void pv_one(f32x16& od, int vb, bf16x8 pa0, bf16x8 pa1, bf16x8 pa2, bf16x8 pa3) {
  s16x4 l0 = {}, h0 = {}, l3 = {}, h3 = {};
  if (SKIP != 2) { l0 = tr_read<v_rd_off(D0, 0, 0)>(vb); h0 = tr_read<v_rd_off(D0, 0, 1)>(vb); }
  const s16x4 l1 = tr_read<v_rd_off(D0, 1, 0)>(vb), h1 = tr_read<v_rd_off(D0, 1, 1)>(vb);
  const s16x4 l2 = tr_read<v_rd_off(D0, 2, 0)>(vb), h2 = tr_read<v_rd_off(D0, 2, 1)>(vb);
  if (SKIP != 1) { l3 = tr_read<v_rd_off(D0, 3, 0)>(vb); h3 = tr_read<v_rd_off(D0, 3, 1)>(vb); }
  asm volatile("s_waitcnt lgkmcnt(0)" ::: "memory"); SBAR();
#define PK(L, H) (bf16x8){L[0], L[1], L[2], L[3], H[0], H[1], H[2], H[3]}
  if (SKIP != 2) od = __builtin_amdgcn_mfma_f32_32x32x16_bf16(pa0, PK(l0, h0), od, 0, 0, 0);
  od = __builtin_amdgcn_mfma_f32_32x32x16_bf16(pa1, PK(l1, h1), od, 0, 0, 0);
  od = __builtin_amdgcn_mfma_f32_32x32x16_bf16(pa2, PK(l2, h2), od, 0, 0, 0);
  if (SKIP != 1) od = __builtin_amdgcn_mfma_f32_32x32x16_bf16(pa3, PK(l3, h3), od, 0, 0, 0);
#undef PK
}
template <int SKIP = 0>
__device__ __forceinline__ void pv_d0(f32x16* o, int vb, bf16x8 pa0, bf16x8 pa1, bf16x8 pa2, bf16x8 pa3) {
  pv_one<0, SKIP>(o[0], vb, pa0, pa1, pa2, pa3); pv_one<1, SKIP>(o[1], vb, pa0, pa1, pa2, pa3); pv_one<2, SKIP>(o[2], vb, pa0, pa1, pa2, pa3); pv_one<3, SKIP>(o[3], vb, pa0, pa1, pa2, pa3);
}
struct NaInfo { int r0, rs_lo; const float* tab; float mfix; };
template <unsigned M0 = 0xFFFFu, unsigned M1 = 0xFFFFu>
__device__ __forceinline__ void na_mask(f32x16& p0, f32x16& p1, int j, const NaInfo& na, int wid, int r32, int hi) {
  if (j < 4) return;
  const int rq = na.r0 + (wid >> 1); int rsq = rq - 4; rsq = rsq < 0 ? 0 : (rsq > 56 ? 56 : rsq);
  const int kr = na.rs_lo + (j - 4);
  const bool valid = (kr >= rsq) && (kr < rsq + 8);
  if (!valid) {
#pragma unroll
    for (int r = 0; r < 16; ++r) { p0[r] = NEGBIG; p1[r] = NEGBIG; }
    return;
  }
  const int dr = kr - rq + 7;
  const int c = (wid & 1) * 32 + r32; int cs = c - 8; cs = cs < 0 ? 0 : (cs > 48 ? 48 : cs);
  const float* tb = na.tab + 64 + dr * 31 - c + 15 + 4 * hi;
  const int t0 = 4 * hi - cs;
#pragma unroll
  for (int r = 0; r < 16; ++r) {
    const int o = (r & 3) + 8 * (r >> 2);
    { const bool in = (unsigned)(t0 + o) < 16u; const float bsv = tb[o]; p0[r] = ((M0 >> r) & 1u) ? (in ? p0[r] + bsv : NEGBIG) : NEGBIG; }
    { const bool in = (unsigned)(t0 + o + 32) < 16u; const float bsv = tb[o + 32]; p1[r] = ((M1 >> r) & 1u) ? (in ? p1[r] + bsv : NEGBIG) : NEGBIG; }
  }
}
template <int LDQ, int LDK, int LDO, bool NA, bool FIXM = false>
__device__ __forceinline__ void attn_unit(const bf16* __restrict__ Qb, const bf16* __restrict__ Kh, const bf16* __restrict__ Vh, bf16* __restrict__ Ob,
                                          int NT, int nfirst, int first0, int second0, char* lds, const NaInfo na) {
  const int tid = ltid(), wid = tid >> 6, lane = tid & 63, r32 = lane & 31, hi = lane >> 5;
  bf16* V_lds = (bf16*)lds; bf16* K_lds = (bf16*)(lds + 2 * SHM_V);
  float* ws = (float*)(lds + 2 * SHM_V + 2 * SHM_K) + wid * 64; float* li_l = ws; float* al_l = ws + 32;
  float m_reg = FIXM ? na.mfix : -1e30f, l_reg = 0; f32x16 o[4] = {}; bf16x8 qr[8];
  const bf16* Qw = Qb + (long)(wid * QBLK + r32) * LDQ + hi * 8;
#pragma unroll
  for (int d0 = 0; d0 < 8; ++d0) qr[d0] = *reinterpret_cast<const bf16x8*>(Qw + d0 * 16);
  const int sr = tid >> 4, sc = (tid & 15) * 8, vst0 = v_st(sr, sc), vst1 = v_st(32 + sr, sc);
  const int vb0 = (int)(uintptr_t)V_lds + v_rd_base(lane);
  struct { bf16x8 vs0, vs1, ks0, ks1; } sr_[2];
#define KROW(j) ((j) < nfirst ? first0 + 64 * (j) : second0 + 64 * ((j) - nfirst))
#define SLOAD(i, jt) do { const long k0_ = KROW(jt); sr_[i].vs0 = *reinterpret_cast<const bf16x8*>(&Vh[(k0_ + sr) * LDK + sc]); sr_[i].vs1 = *reinterpret_cast<const bf16x8*>(&Vh[(k0_ + 32 + sr) * LDK + sc]); \
    sr_[i].ks0 = *reinterpret_cast<const bf16x8*>(&Kh[(k0_ + sr) * LDK + sc]); sr_[i].ks1 = *reinterpret_cast<const bf16x8*>(&Kh[(k0_ + 32 + sr) * LDK + sc]); } while (0)
#define SWRITE(b, i) do { *(bf16x8*)((char*)V_lds + (b) * SHM_V + vst0) = sr_[i].vs0;          \
    *(bf16x8*)((char*)V_lds + (b) * SHM_V + vst1) = sr_[i].vs1; int kc = sc * 2;               \
    *(bf16x8*)((char*)K_lds + (b) * SHM_K + KSWZ(sr, kc)) = sr_[i].ks0;                       \
    *(bf16x8*)((char*)K_lds + (b) * SHM_K + KSWZ(32 + sr, kc)) = sr_[i].ks1; } while (0)
#define SWAIT() asm volatile("s_waitcnt vmcnt(4)" ::: "memory")
#define RESC(a) do { if (!FIXM && __any((a) < 1.f)) { if (hi == 0) al_l[r32] = (a); asm volatile("s_waitcnt lgkmcnt(0)" ::: "memory"); \
    for (int d = 0; d < 4; ++d) for (int r = 0; r < 16; ++r) o[d][r] *= al_l[crow(r, hi)]; } } while (0)
  f32x16 pA0, pA1, pB0, pB1; float mnA, mnB, alA, alB; bf16x8 pa0, pa1, pa2, pa3;
  constexpr int SE = 0, SO = 1;
  SLOAD(SE, 0); asm volatile("s_waitcnt vmcnt(0)" ::: "memory"); SWRITE(0, SE); __syncthreads();
  qkt(pA0, pA1, K_lds, qr, r32, hi); if (NA) na_mask(pA0, pA1, 0, na, wid, r32, hi); partialSM<FIXM>(pA0, pA1, m_reg, mnA, alA);
  SLOAD(SO, 1); if (2 < NT) SLOAD(SE, 2);
  SWAIT(); SWRITE(1, SO); __syncthreads();
  for (int j = 1; j + 1 < NT; j += 2) {
    SBAR(); qkt(pB0, pB1, (bf16*)((char*)K_lds + SHM_K), qr, r32, hi); if (NA) na_mask(pB0, pB1, j, na, wid, r32, hi);
    finishSM<FIXM>(pA0, pA1, alA, l_reg, pa0, pa1, pa2, pa3, na.mfix); SBAR();
    SLOAD(SO, (j + 2)); SBAR();
    pv_d0(o, vb0, pa0, pa1, pa2, pa3); partialSM<FIXM>(pB0, pB1, m_reg, mnB, alB);
    __syncthreads(); SWAIT(); SWRITE(0, SE);
    RESC(alB); __syncthreads();
    SBAR(); qkt(pA0, pA1, K_lds, qr, r32, hi); if (NA) na_mask(pA0, pA1, j + 1, na, wid, r32, hi);
    finishSM<FIXM>(pB0, pB1, alB, l_reg, pa0, pa1, pa2, pa3, na.mfix); SBAR();
    if (j + 3 < NT) SLOAD(SE, (j + 3)); SBAR();
    pv_d0(o, vb0 + (int)SHM_V, pa0, pa1, pa2, pa3); partialSM<FIXM>(pA0, pA1, m_reg, mnA, alA);
    __syncthreads(); SWAIT(); SWRITE(1, SO);
    RESC(alA); __syncthreads();
  }
  SBAR(); qkt(pB0, pB1, (bf16*)((char*)K_lds + SHM_K), qr, r32, hi); if (NA) na_mask(pB0, pB1, NT - 1, na, wid, r32, hi);
  finishSM<FIXM>(pA0, pA1, alA, l_reg, pa0, pa1, pa2, pa3, na.mfix); SBAR();
  pv_d0(o, vb0, pa0, pa1, pa2, pa3); partialSM<FIXM>(pB0, pB1, m_reg, mnB, alB);
  __syncthreads(); RESC(alB);
  finishSM<FIXM>(pB0, pB1, alB, l_reg, pa0, pa1, pa2, pa3, na.mfix); SBAR();
  pv_d0(o, vb0 + (int)SHM_V, pa0, pa1, pa2, pa3);
  if (hi == 0) li_l[r32] = l_reg; asm volatile("s_waitcnt lgkmcnt(0)" ::: "memory");
  float rli[16];
#pragma unroll
  for (int r = 0; r < 16; ++r) rli[r] = __builtin_amdgcn_rcpf(li_l[crow(r, hi)]);
  bf16* Ow = Ob + (long)(wid * QBLK) * LDO;
#pragma unroll
  for (int r = 0; r < 16; ++r) { int orow = crow(r, hi);
#pragma unroll
    for (int d0 = 0; d0 < 4; ++d0) Ow[(long)orow * LDO + d0 * 32 + r32] = (bf16)(cvtpk(o[d0][r] * rli[r], 0.f) & 0xffffu); }
  __syncthreads();
#undef KROW
#undef SLOAD
#undef SWRITE
#undef SWAIT
#undef RESC
}

template <int LDQ, int LDK, int LDO, bool NA, bool FIXM = false>
__device__ __forceinline__ void attn_unit_simple(const bf16* __restrict__ Qb, const bf16* __restrict__ Kh, const bf16* __restrict__ Vh, bf16* __restrict__ Ob,
                                                 int NT, int nfirst, int first0, int second0, char* lds, const NaInfo na) {
  const int tid = ltid(), wid = tid >> 6, lane = tid & 63, r32 = lane & 31, hi = lane >> 5;
  bf16* V_lds = (bf16*)lds; bf16* K_lds = (bf16*)(lds + 2 * SHM_V);
  float* ws = (float*)(lds + 2 * SHM_V + 2 * SHM_K) + wid * 64; float* li_l = ws; float* al_l = ws + 32;
  float m_reg = FIXM ? na.mfix : -1e30f, l_reg = 0; f32x16 o[4] = {}; bf16x8 qr[8];
  const bf16* Qw = Qb + (long)(wid * QBLK + r32) * LDQ + hi * 8;
#pragma unroll
  for (int d0 = 0; d0 < 8; ++d0) qr[d0] = *reinterpret_cast<const bf16x8*>(Qw + d0 * 16);
  const int sr = tid >> 4, sc = (tid & 15) * 8, vst0 = v_st(sr, sc), vst1 = v_st(32 + sr, sc);
  const int vb0 = (int)(uintptr_t)V_lds + v_rd_base(lane);
  bf16x8 vs0, vs1, ks0, ks1;
#define KROW(j) ((j) < nfirst ? first0 + 64 * (j) : second0 + 64 * ((j) - nfirst))
#define SLOAD1(jt) do { const long k0_ = KROW(jt); vs0 = *reinterpret_cast<const bf16x8*>(&Vh[(k0_ + sr) * LDK + sc]); vs1 = *reinterpret_cast<const bf16x8*>(&Vh[(k0_ + 32 + sr) * LDK + sc]); \
    ks0 = *reinterpret_cast<const bf16x8*>(&Kh[(k0_ + sr) * LDK + sc]); ks1 = *reinterpret_cast<const bf16x8*>(&Kh[(k0_ + 32 + sr) * LDK + sc]); } while (0)
#define SWRITE1(b) do { *(bf16x8*)((char*)V_lds + (b) * SHM_V + vst0) = vs0; *(bf16x8*)((char*)V_lds + (b) * SHM_V + vst1) = vs1; int kc = sc * 2; \
    *(bf16x8*)((char*)K_lds + (b) * SHM_K + KSWZ(sr, kc)) = ks0; *(bf16x8*)((char*)K_lds + (b) * SHM_K + KSWZ(32 + sr, kc)) = ks1; } while (0)
  SLOAD1(0); asm volatile("s_waitcnt vmcnt(0)" ::: "memory"); SWRITE1(0); __syncthreads();
  for (int j = 0; j < NT; ++j) {
    const int bsel = j & 1;
    if (j + 1 < NT) SLOAD1(j + 1);
    bool live = true;
    if (NA && j >= 4) { const int rq = na.r0 + (wid >> 1); int rsq = rq - 4; rsq = rsq < 0 ? 0 : (rsq > 56 ? 56 : rsq); const int kr = na.rs_lo + (j - 4); live = (kr >= rsq) && (kr < rsq + 8); }
    if (live) {
    f32x16 p0, p1; float mn, alpha; bf16x8 pa0, pa1, pa2, pa3;
    SBAR(); qkt(p0, p1, (bf16*)((char*)K_lds + bsel * SHM_K), qr, r32, hi);
    const int nsel = (NA && j >= 4) ? 1 + (wid & 1) : 0;
    if (nsel == 1) { na_mask<0xFFFFu, 0x000Fu>(p0, p1, j, na, wid, r32, hi); partialSM_m<0xFFFFu, 0x000Fu, FIXM>(p0, p1, m_reg, mn, alpha); }
    else if (nsel == 2) { na_mask<0xF000u, 0xFFFFu>(p0, p1, j, na, wid, r32, hi); partialSM_m<0xF000u, 0xFFFFu, FIXM>(p0, p1, m_reg, mn, alpha); }
    else partialSM<FIXM>(p0, p1, m_reg, mn, alpha);
    if (!FIXM && __any(alpha < 1.f)) { if (hi == 0) al_l[r32] = alpha; asm volatile("s_waitcnt lgkmcnt(0)" ::: "memory");
#pragma unroll
      for (int d = 0; d < 4; ++d)
#pragma unroll
        for (int r = 0; r < 16; ++r) o[d][r] *= al_l[crow(r, hi)]; }
    if (nsel == 1) finishSM_m<0xFFFFu, 0x000Fu>(p0, p1, alpha, l_reg, pa0, pa1, pa2, pa3);
    else if (nsel == 2) finishSM_m<0xF000u, 0xFFFFu>(p0, p1, alpha, l_reg, pa0, pa1, pa2, pa3);
    else finishSM<FIXM>(p0, p1, alpha, l_reg, pa0, pa1, pa2, pa3, na.mfix);
    SBAR();
    if (nsel == 1) pv_d0<1>(o, vb0 + bsel * (int)SHM_V, pa0, pa1, pa2, pa3);
    else if (nsel == 2) pv_d0<2>(o, vb0 + bsel * (int)SHM_V, pa0, pa1, pa2, pa3);
    else pv_d0<0>(o, vb0 + bsel * (int)SHM_V, pa0, pa1, pa2, pa3);
    }
    if (j + 1 < NT) { asm volatile("s_waitcnt vmcnt(0)" ::: "memory"); SWRITE1(bsel ^ 1); }
    __syncthreads();
  }
  if (hi == 0) li_l[r32] = l_reg; asm volatile("s_waitcnt lgkmcnt(0)" ::: "memory");
  float rli[16];
#pragma unroll
  for (int r = 0; r < 16; ++r) rli[r] = __builtin_amdgcn_rcpf(li_l[crow(r, hi)]);
  bf16* Ow = Ob + (long)(wid * QBLK) * LDO;
#pragma unroll
  for (int r = 0; r < 16; ++r) { int orow = crow(r, hi);
#pragma unroll
    for (int d0 = 0; d0 < 4; ++d0) Ow[(long)orow * LDO + d0 * 32 + r32] = (bf16)(cvtpk(o[d0][r] * rli[r], 0.f) & 0xffffu); }
  __syncthreads();
#undef KROW
#undef SLOAD1
#undef SWRITE1
}
}

constexpr int RING_OFF = 0, RING_BYTES = 131072;
constexpr int LDSCTL_OFF = RING_BYTES, MISC_OFF = LDSCTL_OFF + 320;
constexpr int LDS_BYTES = 147456;
#define RLX_AGENT __ATOMIC_RELAXED, __HIP_MEMORY_SCOPE_AGENT

#define XB_TMO      128
#define XB_XCNT(j)  (256  + 64 * (j))
#define XB_XSUB(j)  (1280 + 64 * (j))
#define XB_XGEN(j)  (2304 + 64 * (j))
#define XB_TOP      3328
#define XB_TOPGEN   3392
#define XCD_BAR_WORDS 3456
#define XB_SPIN_CAP (1u << 18)
__device__ __forceinline__ unsigned xb_ld(unsigned* p)              { return __hip_atomic_load(p, __ATOMIC_RELAXED, __HIP_MEMORY_SCOPE_AGENT); }
__device__ __forceinline__ unsigned xb_add(unsigned* p, unsigned v) { return __hip_atomic_fetch_add(p, v, __ATOMIC_RELAXED, __HIP_MEMORY_SCOPE_AGENT); }
__device__ __forceinline__ unsigned xb_xcc_id() { return (unsigned)__builtin_amdgcn_s_getreg((3 << 11) | 20) & 0xFu; }
#define XB_SPIN(cond, bar) do { unsigned _sp = 0; while (cond) { __builtin_amdgcn_s_sleep(1); \
    if ((++_sp & 255u) == 0u) { if (xb_ld(&(bar)[XB_TMO])) break; if (_sp > XB_SPIN_CAP) { atomicAdd(&(bar)[XB_TMO], 1u); break; } } } } while (0)
struct XcdBarrier { unsigned* bar; unsigned x; volatile LAS unsigned* st; };
__device__ __forceinline__ XcdBarrier xcd_barrier_post(unsigned* bar, volatile LAS unsigned* st) {
    XcdBarrier b; b.bar = bar; b.x = xb_xcc_id(); b.st = st;
    if (threadIdx.x == 0) (void)xb_add(&bar[XB_XCNT(b.x)], 1u);
    return b;
}
__device__ __forceinline__ void xcd_barrier_complete(unsigned* bar, unsigned x, unsigned& nloc, unsigned& nx) {
    const unsigned G = gridDim.x * gridDim.y * gridDim.z;
    unsigned sum, cnt, mine, sp = 0u;
    for (;;) {
        sum = 0u; cnt = 0u; mine = 0u;
#pragma unroll
        for (unsigned j = 0; j < 16; ++j) { const unsigned c = xb_ld(&bar[XB_XCNT(j)]); sum += c; cnt += (c > 0u) ? 1u : 0u; mine = (j == x) ? c : mine; }
        if (sum == G) break;
        __builtin_amdgcn_s_sleep(1);
        if ((++sp & 255u) == 0u) { if (xb_ld(&bar[XB_TMO])) break; if (sp > XB_SPIN_CAP) { atomicAdd(&bar[XB_TMO], 1u); break; } }
    }
    nloc = mine > 0u ? mine : 1u; nx = cnt > 0u ? cnt : 1u;
}
__device__ __forceinline__ void xcd_barrier(const XcdBarrier& b) {
    asm volatile("s_waitcnt vmcnt(0)" ::: "memory");
    __syncthreads();
    if (threadIdx.x == 0) {
        unsigned* bar = b.bar;
        __builtin_amdgcn_s_waitcnt(0);
        unsigned nloc = b.st[0], nx = b.st[1];
        if (nloc == 0u) { xcd_barrier_complete(bar, b.x, nloc, nx); b.st[0] = nloc; b.st[1] = nx; }
        const unsigned old = xb_add(&bar[XB_XSUB(b.x)], 1u);
        const unsigned gen = old / nloc;
        if (old + 1u == (gen + 1u) * nloc) {
            __builtin_amdgcn_fence(__ATOMIC_RELEASE, "agent");
            asm volatile("s_waitcnt vmcnt(0)" ::: "memory");
            const unsigned og = xb_add(&bar[XB_TOP], 1u);
            const unsigned tg = og / nx;
            if (og + 1u == (tg + 1u) * nx) xb_add(&bar[XB_TOPGEN], 1u);
            else XB_SPIN(xb_ld(&bar[XB_TOPGEN]) == tg, bar);
            __builtin_amdgcn_fence(__ATOMIC_ACQUIRE, "agent");
            xb_add(&bar[XB_XGEN(b.x)], 1u);
            asm volatile("s_waitcnt vmcnt(0)" ::: "memory");
        } else {
            XB_SPIN(xb_ld(&bar[XB_XGEN(b.x)]) == gen, bar);
            __builtin_amdgcn_fence(__ATOMIC_ACQUIRE, "agent");
            asm volatile("s_waitcnt vmcnt(0)" ::: "memory");
        }
    }
    __syncthreads();
}
constexpr int CW_BAR = 4096;

struct Frame {
    LAS unsigned char* lds; unsigned char* ldsg;
    int tid, lane, wave, vcu, G, gw, NGW;
    unsigned char* ws; const float* const* in; float* out;
};
__device__ __forceinline__ int row_seqinfo(int row, int& pos, int& len) {
    const int b = row / SB, t = row - b * SB;
    if (t >= SEQ) { pos = t - SEQ; len = CTXL; return 2; }
    pos = t; len = SEQ; return b;
}

__device__ __forceinline__ void transpose_item(const float* W, int ldw, bf16* WT, int ldk, int row_off, LAS float* scr, int kb, int nb, int lane, int rstride = 1) {
    const int k0 = 64 * kb, n0 = 32 * nb;
    float tv[32];
#pragma unroll
    for (int i = 0; i < 32; ++i) tv[i] = __builtin_nontemporal_load(W + (size_t)(k0 + 2 * i + (lane >> 5)) * ldw + n0 + (lane & 31));
#pragma unroll
    for (int i = 0; i < 32; ++i) scr[(2 * i + (lane >> 5)) * 33 + (lane & 31)] = tv[i];
    asm volatile("s_waitcnt lgkmcnt(0)" ::: "memory");
    const int c = lane & 7;
#pragma unroll
    for (int j = 0; j < 4; ++j) { const int n = (lane >> 3) + 8 * j; const LAS float* s = scr + (8 * c) * 33 + n;
        v4u o; o.x = cvt_pk_bf16(s[0 * 33], s[1 * 33]); o.y = cvt_pk_bf16(s[2 * 33], s[3 * 33]); o.z = cvt_pk_bf16(s[4 * 33], s[5 * 33]); o.w = cvt_pk_bf16(s[6 * 33], s[7 * 33]);
        *(v4u*)(WT + (size_t)(row_off + n0 + rstride * n) * ldk + k0 + 8 * c) = o; }
    asm volatile("s_waitcnt lgkmcnt(0)" ::: "memory");
}
struct TJob { int in_idx; unsigned long long in_off; int K, N; unsigned long long dst_off; int row_off; };
#define NTJ 20
__constant__ TJob g_tj[NTJ] = {
    {8, 0ull * 2048 * 11264, 2048, 11264, WS_UPT + 0ull * 11264 * 2048 * 2, -1}, {8, 1ull * 2048 * 11264, 2048, 11264, WS_UPT + 1ull * 11264 * 2048 * 2, -1},
    {8, 2ull * 2048 * 11264, 2048, 11264, WS_UPT + 2ull * 11264 * 2048 * 2, -1}, {8, 3ull * 2048 * 11264, 2048, 11264, WS_UPT + 3ull * 11264 * 2048 * 2, -1},
    {11, 0ull * 5632 * 2048, 5632, 2048, WS_DNT + 0ull * 2048 * 5632 * 2, 0}, {11, 1ull * 5632 * 2048, 5632, 2048, WS_DNT + 1ull * 2048 * 5632 * 2, 0},
    {11, 2ull * 5632 * 2048, 5632, 2048, WS_DNT + 2ull * 2048 * 5632 * 2, 0}, {11, 3ull * 5632 * 2048, 5632, 2048, WS_DNT + 3ull * 2048 * 5632 * 2, 0},
    {13, 0ull * 2048 * 2048, 2048, 2048, WS_RWT, 0}, {13, 1ull * 2048 * 2048, 2048, 2048, WS_RWT, 2048}, {13, 2ull * 2048 * 2048, 2048, 2048, WS_RWT, 4096},
    {13, 3ull * 2048 * 2048, 2048, 2048, WS_RWT + 28ull * 256 * 2048 * 2, 0}, {13, 4ull * 2048 * 2048, 2048, 2048, WS_RWT + 28ull * 256 * 2048 * 2, 2048}, {13, 5ull * 2048 * 2048, 2048, 2048, WS_RWT + 28ull * 256 * 2048 * 2, 4096},
    {27, 0, 2048, 2048, WS_RWOT, 0}, {27, 1ull * 2048 * 2048, 2048, 2048, WS_RWOT + 2048ull * 2048 * 2, 0},
    {31, 0, 2048, 6144, WS_NAQKVT, 0}, {35, 0, 2048, 2048, WS_NAOT, 0}, {36, 0, 2048, 3072, WS_GAQKVT, -2}, {39, 0, 2048, 2048, WS_GAOT, 0},
};
__device__ __forceinline__ void pro_transposes(Frame& F) {
    LAS float* scr = (LAS float*)(F.lds + RING_OFF + F.wave * 16384);
    int base = 0;
    for (int jb = 0; jb < NTJ; ++jb) {
        const int K = g_tj[jb].K, N = g_tj[jb].N, nkb = K / 64, nnb = N / 32, nit = (nkb / 2) * nnb;
        const float* W = F.in[g_tj[jb].in_idx] + g_tj[jb].in_off; bf16* WT = (bf16*)(F.ws + g_tj[jb].dst_off); const int ro = g_tj[jb].row_off;
        int first = (F.gw - base % F.NGW + F.NGW) % F.NGW;
        for (int it = first; it < nit; it += F.NGW) {
            const int nb = it % nnb; int roff = ro;
            if (ro < 0) { const int n0 = 32 * nb, nn = n0 < DFF ? n0 : n0 - DFF; roff = ((nn >> 7) * 256 + (n0 < DFF ? 0 : 128) + (nn & 127)) - n0; }
            int rstr = 1;
            if (ro == -2) { const int n0 = 32 * nb; roff = 0; if (n0 < 2560) { roff = ((n0 >> 6) * 64 + ((n0 >> 5) & 1)) - n0; rstr = 2; } }
            transpose_item(W, N, WT, K, roff, scr, 2 * (it / nnb), nb, F.lane, rstr);
            transpose_item(W, N, WT, K, roff, scr, 2 * (it / nnb) + 1, nb, F.lane, rstr);
        }
        base += nit;
    }
}
__device__ __forceinline__ void pro_small(Frame& F) {
    const size_t gt = (size_t)F.vcu * 512 + F.tid, NT = (size_t)F.G * 512;
    for (int j = 0; j < 2; ++j) {
        bf16* RWT = (bf16*)(F.ws + WS_RWT) + (size_t)j * 28 * 256 * 2048;
        for (size_t i = gt; i < (size_t)1024 * 2048; i += NT) {
            const int rr = (int)(i / 2048), k = (int)(i % 2048), blk = rr >> 8, n = rr & 255; float v = 0.f;
            if (blk == 0) { const int d = n >> 7, q = n & 127; if (q < 96) v = F.in[15][(((size_t)j * 2 + d) * 2048 + k) * 96 + q]; }
            else if (blk == 1) { const int d = n >> 7, q = n & 127; if (q < 96) v = F.in[18][(((size_t)j * 2 + d) * 2048 + k) * 96 + q]; }
            else if (blk == 2) { v = F.in[20][((size_t)j * 2048 + k) * 256 + n]; }
            else { if (j == 1 && n < 64) v = F.in[29][(size_t)k * 64 + n]; }
            RWT[(size_t)(6144 + rr) * 2048 + k] = (bf16)(cvt_pk_bf16(v, 0.f) & 0xffffu);
        }
        bf16* L2T = (bf16*)(F.ws + WS_RL2T) + (size_t)j * 48 * 256 * 256;
        for (size_t i = gt; i < (size_t)12288 * 256; i += NT) {
            const int rr = (int)(i / 256), k = (int)(i % 256); float v = 0.f;
            if (rr < 4096) { const int d = rr / 2048, c = rr % 2048; const int kk = k - d * 128; if (kk >= 0 && kk < 96) v = F.in[16][(((size_t)j * 2 + d) * 96 + kk) * 2048 + c]; }
            else if (rr < 8192) { const int r2 = rr - 4096, d = r2 / 2048, c = r2 % 2048; const int kk = k - d * 128; if (kk >= 0 && kk < 96) v = F.in[19][(((size_t)j * 2 + d) * 96 + kk) * 2048 + c]; }
            else if (rr < 10240) { const int c = rr - 8192; v = F.in[21][((size_t)j * 256 + k) * 2048 + c]; }
            else { const int c = rr - 10240; if (j == 1 && k < 64) v = F.in[30][(size_t)k * 2048 + c]; }
            L2T[i] = (bf16)(cvt_pk_bf16(v, 0.f) & 0xffffu);
        }
    }
}
__device__ __forceinline__ void pro_mod(Frame& F) {
    LAS float* sl = (LAS float*)(F.lds + RING_OFF);
    LAS float* red = (LAS float*)(F.lds + RING_OFF + 32768);
    for (int i = F.tid; i < 3 * 2048; i += 512) { const int s = i / 2048, d = i % 2048; const float c = (s < 2) ? F.in[1][s * 2048 + d] : F.in[3][d]; sl[i] = c * sigmoidf_(c); }
    __syncthreads();
    float* MOD = (float*)(F.ws + WS_MOD);
    for (int it = F.vcu; it < 256; it += F.G) {
        const int l = it >> 6, blk = it & 63, col = 192 * blk + 3 * F.lane;
        const float* W = F.in[4] + (size_t)l * 2048 * 12288 + col;
        float a[3][3];
#pragma unroll
        for (int s = 0; s < 3; ++s) { a[s][0] = 0.f; a[s][1] = 0.f; a[s][2] = 0.f; }
        const int d0 = F.wave * 256;
#pragma unroll 8
        for (int dd = 0; dd < 256; ++dd) {
            const int d = d0 + dd; const float* wp = W + (size_t)d * 12288;
            const float w0 = __builtin_nontemporal_load(wp), w1 = __builtin_nontemporal_load(wp + 1), w2 = __builtin_nontemporal_load(wp + 2);
#pragma unroll
            for (int s = 0; s < 3; ++s) { const float sv = sl[s * 2048 + d]; a[s][0] += sv * w0; a[s][1] += sv * w1; a[s][2] += sv * w2; }
        }
#pragma unroll
        for (int s = 0; s < 3; ++s)
#pragma unroll
            for (int e = 0; e < 3; ++e) red[(F.wave * 9 + s * 3 + e) * 64 + F.lane] = a[s][e];
        __syncthreads();
        for (int idx = F.tid; idx < 576; idx += 512) {
            const int s = idx / 192, cc = idx % 192, ln = cc / 3, e = cc % 3; float v = 0.f;
#pragma unroll
            for (int w = 0; w < 8; ++w) v += red[(w * 9 + s * 3 + e) * 64 + ln];
            const int j = 192 * blk + cc;
            MOD[((size_t)l * 3 + s) * 12288 + j] = v + F.in[5][(size_t)l * 12288 + j];
        }
        __syncthreads();
    }
}

__device__ __forceinline__ void phase_norm(Frame& F, const float* gain, const float* mod3  , bf16* Hout, float* H32, int nparts, const float* pgate  , int lat_only,
                                           const float* xin_lat = nullptr, const float* xin_ctx = nullptr  ) {
    bf16* X = (bf16*)(F.ws + WS_X); const float* PART = (const float*)(F.ws + WS_PART);
    for (int li = F.gw; li < NB * SEQ; li += F.NGW) {
        const int s = li / SEQ, pos = li - s * SEQ, row = s * SB + pos;
        v2u* xr = (v2u*)(X + (size_t)row * D) + F.lane;
        f32x4 v[8]; float ss = 0.f;
        if (xin_lat) { const f32x4* xs = (const f32x4*)(xin_lat + ((size_t)s * SEQ + pos) * D) + F.lane;
#pragma unroll
            for (int j = 0; j < 8; ++j) v[j] = xs[64 * j];
        } else {
#pragma unroll
            for (int j = 0; j < 8; ++j) { const v2u t_ = xr[64 * j]; v[j] = (f32x4){bflo(t_.x), bfhi(t_.x), bflo(t_.y), bfhi(t_.y)}; }
        }
#pragma unroll
        for (int j = 0; j < 8; ++j) ss += (v[j].x * v[j].x + v[j].y * v[j].y) + (v[j].z * v[j].z + v[j].w * v[j].w);
        const float rstd = rsqrtf(wave_sum(ss) * (1.f / D) + NORM_EPS);
        const float* sh = mod3 + (size_t)s * (6 * D); const float* sc = sh + D;
#pragma unroll
        for (int j = 0; j < 8; ++j) {
            const int col = 4 * F.lane + 256 * j;
            const f32x4 g = *(const f32x4*)(gain + col), a = *(const f32x4*)(sc + col), b = *(const f32x4*)(sh + col);
            f32x4 y = v[j] * rstd * g; y = y * (a + 1.0f) + b;
            v2u o; o.x = cvt_pk_bf16(y.x, y.y); o.y = cvt_pk_bf16(y.z, y.w);
            *(v2u*)(Hout + (size_t)row * D + col) = o;
            if (H32) *(f32x4*)(H32 + (size_t)row * D + col) = y;
        }
    }
    if (lat_only) return;
    LAS float* red = (LAS float*)(F.lds + RING_OFF);
    int par = 0;
    for (int ci = F.vcu; ci < NB * CTXL; ci += F.G, par ^= 1) {
        const int bb = ci / CTXL, pos = ci - bb * CTXL, row = bb * SB + SEQ + pos, col = 256 * F.wave + 4 * F.lane;
        v2u* xr = (v2u*)(X + (size_t)row * D + col);
        f32x4 v;
        if (xin_ctx) v = *(const f32x4*)(xin_ctx + ((size_t)bb * CTXL + pos) * D + col);
        else { const v2u t_ = *xr; v = (f32x4){bflo(t_.x), bfhi(t_.x), bflo(t_.y), bfhi(t_.y)}; }
        if (nparts > 0) {
            f32x4 pv[11];
#pragma unroll
            for (int k = 0; k < 11; ++k) pv[k] = (k < nparts) ? *(const f32x4*)(PART + ((size_t)k * 512 + ci) * D + col) : (f32x4){0.f, 0.f, 0.f, 0.f};
            f32x4 a = pv[0];
#pragma unroll
            for (int k = 1; k < 11; ++k) a += pv[k];
            v += a * *(const f32x4*)(pgate + col);
        }
        if (nparts > 0 || xin_ctx) { v2u t_; t_.x = cvt_pk_bf16(v.x, v.y); t_.y = cvt_pk_bf16(v.z, v.w); *xr = t_; }
        const float ssw = wave_sum((v.x * v.x + v.y * v.y) + (v.z * v.z + v.w * v.w));
        if (F.lane == 0) red[par * 8 + F.wave] = ssw;
        __syncthreads();
        float ss = 0.f;
#pragma unroll
        for (int w = 0; w < 8; ++w) ss += red[par * 8 + w];
        const float rstd = rsqrtf(ss * (1.f / D) + NORM_EPS);
        const float* sh = mod3 + (size_t)2 * (6 * D); const float* sc = sh + D;
        const f32x4 g = *(const f32x4*)(gain + col), a_ = *(const f32x4*)(sc + col), b_ = *(const f32x4*)(sh + col);
        f32x4 y = v * rstd * g; y = y * (a_ + 1.0f) + b_;
        v2u o; o.x = cvt_pk_bf16(y.x, y.y); o.y = cvt_pk_bf16(y.z, y.w);
        *(v2u*)(Hout + (size_t)row * D + col) = o;
        if (H32) *(f32x4*)(H32 + (size_t)row * D + col) = y;
    }
    __syncthreads();
}
__device__ __forceinline__ void phase_xm(Frame& F, const float* mu  ) {
    const bf16* Hb = (const bf16*)(F.ws + WS_H); bf16* XM = (bf16*)(F.ws + WS_XM);
    for (int it = F.gw; it < 4 * M; it += F.NGW) {
        const int row = it >> 2, jq = it & 3;
        int pos, len; (void)row_seqinfo(row, pos, len);
        const bool hp = pos > 0, hn = pos + 1 < len;
#pragma unroll
        for (int j2 = 0; j2 < 2; ++j2) {
            const int j = 2 * jq + j2;
            const int col = 4 * F.lane + 256 * j;
            const v2u z2 = {0u, 0u};
            const v2u hr = *(const v2u*)(Hb + (size_t)row * D + col);
            const v2u ar = hp ? *(const v2u*)(Hb + (size_t)(row - 1) * D + col) : z2, br = hn ? *(const v2u*)(Hb + (size_t)(row + 1) * D + col) : z2;
            const f32x4 h = {bflo(hr.x), bfhi(hr.x), bflo(hr.y), bfhi(hr.y)}, a = {bflo(ar.x), bfhi(ar.x), bflo(ar.y), bfhi(ar.y)}, b = {bflo(br.x), bfhi(br.x), bflo(br.y), bfhi(br.y)};
            const f32x4 xx = (a + b) * 0.5f - h;
#pragma unroll
            for (int p = 0; p < 6; ++p) {
                const f32x4 m = *(const f32x4*)(mu + p * D + col); const f32x4 y = h + xx * m;
                v2u o; o.x = cvt_pk_bf16(y.x, y.y); o.y = cvt_pk_bf16(y.z, y.w);
                *(v2u*)(XM + ((size_t)p * M + row) * D + col) = o;
            }
        }
    }
}
constexpr int SCH = 16, NCHUNK = SB / SCH;
__device__ __forceinline__ int rho0(int hi, int i) { return (i & 3) + 4 * hi + 8 * (i >> 2); }
__device__ __forceinline__ int chunk_row0(int b, int d, int c) { const int sg = 16 * c; if (sg < CTXL) return b * SB + SEQ + (d ? CTXL - 1 - sg : sg); const int t = sg - CTXL; return b * SB + (d ? SEQ - 1 - t : t); }
__device__ __forceinline__ float sum64(float v) {
    v = sum16(v);
    { const auto x = __builtin_amdgcn_permlane16_swap(__float_as_uint(v), __float_as_uint(v), false, false); v = __uint_as_float(x[0]) + __uint_as_float(x[1]); }
    { const auto x = __builtin_amdgcn_permlane32_swap(__float_as_uint(v), __float_as_uint(v), false, false); v = __uint_as_float(x[0]) + __uint_as_float(x[1]); }
    return v;
}
__device__ __forceinline__ bf16x8 pack8(float a0, float a1, float a2, float a3, float a4, float a5, float a6, float a7) {
    v4u w; w.x = cvt_pk_bf16_v(a0, a1); w.y = cvt_pk_bf16_v(a2, a3); w.z = cvt_pk_bf16_v(a4, a5); w.w = cvt_pk_bf16_v(a6, a7); return __builtin_bit_cast(bf16x8, w);
}
typedef float f32x16 __attribute__((ext_vector_type(16)));
__device__ __forceinline__ bf16x8 mk8(unsigned a, unsigned b, unsigned c, unsigned d) { return __builtin_bit_cast(bf16x8, (v4u){a, b, c, d}); }
__device__ __forceinline__ constexpr int brev4(int s) { return ((s & 1) << 3) | ((s & 2) << 1) | ((s & 4) >> 1) | ((s & 8) >> 3); }
__device__ __forceinline__ float red16x64(const float (&x)[16], int lane) {
    const bool b3 = lane & 8, b2 = lane & 4, b1 = lane & 2, b0 = lane & 1;
    float y[8], z[4], w[2];
#pragma unroll
    for (int i = 0; i < 8; ++i) { const float keep = b3 ? x[2 * i + 1] : x[2 * i], send = b3 ? x[2 * i] : x[2 * i + 1]; y[i] = keep + dppmov<0x140>(send); }
#pragma unroll
    for (int i = 0; i < 4; ++i) { const float keep = b2 ? y[2 * i + 1] : y[2 * i], send = b2 ? y[2 * i] : y[2 * i + 1]; z[i] = keep + dppmov<0x141>(send); }
#pragma unroll
    for (int i = 0; i < 2; ++i) { const float keep = b1 ? z[2 * i + 1] : z[2 * i], send = b1 ? z[2 * i] : z[2 * i + 1]; w[i] = keep + dppmov<0x4E>(send); }
    float v; { const float keep = b0 ? w[1] : w[0], send = b0 ? w[0] : w[1]; v = keep + dppmov<0xB1>(send); }
    { const auto t = __builtin_amdgcn_permlane16_swap(__float_as_uint(v), __float_as_uint(v), false, false); v = __uint_as_float(t[0]) + __uint_as_float(t[1]); }
    { const auto t = __builtin_amdgcn_permlane32_swap(__float_as_uint(v), __float_as_uint(v), false, false); v = __uint_as_float(t[0]) + __uint_as_float(t[1]); }
    return v;
}
constexpr size_t WS_RS = WS_OPS;
constexpr size_t WS_VF = WS_OPS + 2 * MiB;
__device__ __forceinline__ void phase_rs(Frame& F, int j) {
    const bf16* Kt = (const bf16*)(F.ws + WS_RKV + SZ_ACT); const float* k_k = F.in[22] + (size_t)j * D; float* RS = (float*)(F.ws + WS_RS);
    const int lane = F.lane;
    f32x4 kg[8];
#pragma unroll
    for (int i = 0; i < 8; ++i) kg[i] = *(const f32x4*)(k_k + 32 * lane + 4 * i);
    for (int row = F.gw; row < M; row += F.NGW) {
        const v4u* kr = (const v4u*)(Kt + (size_t)row * D + 32 * lane);
        float acc = 0.f;
#pragma unroll
        for (int i = 0; i < 4; ++i) { const v4u t = kr[i];
            const float x0 = bflo(t.x) * kg[2 * i][0], x1 = bfhi(t.x) * kg[2 * i][1], x2 = bflo(t.y) * kg[2 * i][2], x3 = bfhi(t.y) * kg[2 * i][3];
            const float x4 = bflo(t.z) * kg[2 * i + 1][0], x5 = bfhi(t.z) * kg[2 * i + 1][1], x6 = bflo(t.w) * kg[2 * i + 1][2], x7 = bfhi(t.w) * kg[2 * i + 1][3];
            acc += x0 * x0 + x1 * x1 + x2 * x2 + x3 * x3 + x4 * x4 + x5 * x5 + x6 * x6 + x7 * x7; }
        acc += dppmov<0xB1>(acc);
        if (!(lane & 1)) RS[(size_t)row * 32 + (lane >> 1)] = __builtin_amdgcn_rsqf(fmaxf(acc, 1e-24f));
    }
}
constexpr int FS_NS = 8, FS_SLOT = 11776, FS_A4 = 4352, FS_AW = 8448, FS_A23 = 9472, FS_GAM = 10496, FS_V = 10752;
constexpr int FS_SCR = FS_NS * FS_SLOT, FS_SCRSZ = 5440, FS_FLAGS = FS_SCR + 6 * FS_SCRSZ;
static_assert(FS_FLAGS + 64 <= RING_BYTES, "fused scan LDS");
__device__ __forceinline__ bf16x8 fs_frag(const LAS unsigned char* base, int mb, int jj, int m, int g) {
    const v2u lo = *(const LAS v2u*)(base + mb * 2176 + (8 * jj + g) * 136 + m * 8), hh = *(const LAS v2u*)(base + mb * 2176 + (8 * jj + 4 + g) * 136 + m * 8);
    return __builtin_bit_cast(bf16x8, (v4u){lo.x, lo.y, hh.x, hh.y});
}
__device__ __forceinline__ void phase_scanfused(Frame& F, int j, const bf16* Vsrc) {
    const bf16* R = (const bf16*)(F.ws + WS_RKV); const bf16* Kt = (const bf16*)(F.ws + WS_RKV + SZ_ACT);
    const unsigned short* DEC = (const unsigned short*)(F.ws + WS_DEC); const bf16* AA = (const bf16*)(F.ws + WS_AA);
    const float* k_k = F.in[22] + (size_t)j * D; const float* k_a = F.in[23] + (size_t)j * D; const float* r_k = F.in[24] + (size_t)j * D;
    float* BON = (float*)(F.ws + WS_BON); bf16* Y = (bf16*)(F.ws + WS_Y);
    const int lane = F.lane, wave = F.wave, n16 = lane & 15, g = lane >> 4;
    LAS unsigned char* slots = F.lds + RING_OFF;
    volatile LAS unsigned* flg = (volatile LAS unsigned*)(F.lds + RING_OFF + FS_FLAGS);
    for (int u = F.vcu; u < 256; u += F.G) {
        const int chain = u >> 1, vh = u & 1, d = chain & 1, h = (chain >> 1) & 31, b = chain >> 6;
        const int dstep = d ? -1 : 1; const size_t dofs = (size_t)d * M * D;
        if (F.tid < 16) flg[F.tid] = 0u;
        __syncthreads();
        if (wave >= 2) {
            LAS unsigned char* scr = slots + FS_SCR + (wave - 2) * FS_SCRSZ;
            LAS float* GL = (LAS float*)scr;
            LAS float* TL = (LAS float*)(scr + 4352);
            const int ch = h * 64 + lane;
            const float kkg = k_k[ch], kag = k_a[ch], rkg = r_k[ch];
            const int wofs = (lane >> 2) * 136 + (lane & 3) * 2;
            const int vofs = h * 128 + lane * 2;
            const __amdgpu_buffer_rsrc_t rR = __builtin_amdgcn_make_buffer_rsrc((void*)R, 0, 0x7fffffff, 0x00020000), rK = __builtin_amdgcn_make_buffer_rsrc((void*)Kt, 0, 0x7fffffff, 0x00020000);
            const __amdgpu_buffer_rsrc_t rA = __builtin_amdgcn_make_buffer_rsrc((void*)(AA + dofs), 0, 0x7fffffff, 0x00020000), rW = __builtin_amdgcn_make_buffer_rsrc((void*)(DEC + dofs), 0, 0x7fffffff, 0x00020000);
            const float* RS = (const float*)(F.ws + WS_RS);
            while (true) {
                int c; { unsigned old_; const unsigned one_ = (lane == 0) ? 1u : 0u, addr_ = (unsigned)(size_t)(F.lds + RING_OFF + FS_FLAGS + 40);
                    asm volatile("ds_add_rtn_u32 %0, %1, %2\n\ts_waitcnt lgkmcnt(0)" : "=v"(old_) : "v"(addr_), "v"(one_) : "memory"); c = __builtin_amdgcn_readfirstlane((int)old_); }
                if (c >= NCHUNK) break;
                const int row0 = chunk_row0(b, d, c);
                unsigned short rb[16], kb_[16], ab[16], wf[16];
#pragma unroll
                for (int s = 0; s < 16; ++s) { const int so = (row0 + dstep * s) * (D * 2);
                    rb[s] = __builtin_amdgcn_raw_buffer_load_b16(rR, vofs, so, 0); kb_[s] = __builtin_amdgcn_raw_buffer_load_b16(rK, vofs, so, 0);
                    ab[s] = __builtin_amdgcn_raw_buffer_load_b16(rA, vofs, so, 0); wf[s] = __builtin_amdgcn_raw_buffer_load_b16(rW, vofs, so, 0); }
                const float rsv = RS[(size_t)(row0 + dstep * (lane & 15)) * 32 + h];
                const size_t vo_ = (size_t)(row0 + dstep * (lane >> 2)) * D + h * 64 + vh * 32 + (lane & 3) * 8;
                v4u vreg = *(const v4u*)(Vsrc + vo_);
                if (j > 0) {
                    const v4u v0r = *(const v4u*)((const bf16*)(F.ws + WS_V0) + vo_), vgr = *(const v4u*)((const bf16*)(F.ws + WS_VG) + vo_);
                    v4u o;
                    o.x = cvt_pk_bf16(bflo(vreg.x) + (bflo(v0r.x) - bflo(vreg.x)) * bflo(vgr.x), bfhi(vreg.x) + (bfhi(v0r.x) - bfhi(vreg.x)) * bfhi(vgr.x));
                    o.y = cvt_pk_bf16(bflo(vreg.y) + (bflo(v0r.y) - bflo(vreg.y)) * bflo(vgr.y), bfhi(vreg.y) + (bfhi(v0r.y) - bfhi(vreg.y)) * bfhi(vgr.y));
                    o.z = cvt_pk_bf16(bflo(vreg.z) + (bflo(v0r.z) - bflo(vreg.z)) * bflo(vgr.z), bfhi(vreg.z) + (bfhi(v0r.z) - bfhi(vreg.z)) * bfhi(vgr.z));
                    o.w = cvt_pk_bf16(bflo(vreg.w) + (bflo(v0r.w) - bflo(vreg.w)) * bflo(vgr.w), bfhi(vreg.w) + (bfhi(v0r.w) - bfhi(vreg.w)) * bfhi(vgr.w));
                    vreg = o;
                    if (d == 0) *(v4u*)((bf16*)(F.ws + WS_VF) + vo_) = o;
                }
                if (c >= FS_NS) { const unsigned need = (unsigned)(c - FS_NS + 1); unsigned sp = 0;
                    while (true) { const unsigned d0 = flg[8], d1 = flg[9]; if ((d0 < d1 ? d0 : d1) >= need || ++sp > (1u << 20)) break; __builtin_amdgcn_s_sleep(2); } }
                asm volatile("" ::: "memory");
                LAS unsigned char* sl = slots + (c % FS_NS) * FS_SLOT;
                float rf[16], kf[16], af[16];
#pragma unroll
                for (int s = 0; s < 16; ++s) { rf[s] = bflo(rb[s]); kf[s] = bflo(kb_[s]); af[s] = bflo(ab[s]); }
                if ((c & 1) == vh) {
                    float xs[16];
#pragma unroll
                    for (int s = 0; s < 16; ++s) { const float kd = kf[s] * (1.f + (af[s] - 1.f) * kag); xs[s] = rf[s] * kd * rkg; }
                    const float bnv = red16x64(xs, lane);
                    if (lane < 16) BON[((size_t)d * M + (row0 + dstep * brev4(lane))) * 32 + h] = bnv;
                }
                float G = 1.f; unsigned qprev = 0u, zprev = 0u;
#pragma unroll
                for (int s2 = 0; s2 < 8; ++s2) {
                    float pv[2], rv[2], qv[2], zv[2];
#pragma unroll
                    for (int e = 0; e < 2; ++e) { const int s = 2 * s2 + e;
                        const float r = rf[s], kx = kf[s], a = af[s]; const _Float16 wh = __builtin_bit_cast(_Float16, wf[s]);
                        const float kk = kx * kkg * __uint_as_float((unsigned)__builtin_amdgcn_readlane((int)__float_as_uint(rsv), s));
                        const float bb = kk * a, kd = kx * (1.f + (a - 1.f) * kag);
                        const float gp = G; G = __builtin_fmaf(-G, (float)wh, G); const float inv = __builtin_amdgcn_rcpf(G);
                        pv[e] = gp * kk; rv[e] = G * r; qv[e] = bb * inv; zv[e] = kd * inv; }
                    const unsigned pp = cvt_pk_bf16(pv[0], pv[1]), rr = cvt_pk_bf16(rv[0], rv[1]), qq = cvt_pk_bf16(qv[0], qv[1]), zz = cvt_pk_bf16(zv[0], zv[1]);
                    const int s = 2 * s2;
                    *(LAS unsigned short*)(sl + wofs + s * 8) = (unsigned short)(pp & 0xffffu); *(LAS unsigned short*)(sl + wofs + s * 8 + 8) = (unsigned short)(pp >> 16);
                    *(LAS unsigned short*)(sl + 2176 + wofs + s * 8) = (unsigned short)(rr & 0xffffu); *(LAS unsigned short*)(sl + 2176 + wofs + s * 8 + 8) = (unsigned short)(rr >> 16);
                    *(LAS unsigned short*)(scr + wofs + s * 8) = (unsigned short)(qq & 0xffffu); *(LAS unsigned short*)(scr + wofs + s * 8 + 8) = (unsigned short)(qq >> 16);
                    *(LAS unsigned short*)(scr + 2176 + wofs + s * 8) = (unsigned short)(zz & 0xffffu); *(LAS unsigned short*)(scr + 2176 + wofs + s * 8 + 8) = (unsigned short)(zz >> 16);
                    if (s2 & 1) { *(LAS v2u*)(sl + FS_A4 + lane * 8 + (s2 >> 1) * 1024) = (v2u){qprev ^ 0x80008000u, qq ^ 0x80008000u}; *(LAS v2u*)(sl + FS_A4 + lane * 8 + (s2 >> 1) * 1024 + 512) = (v2u){zprev, zz}; }
                    else { qprev = qq; zprev = zz; }
                }
                *(LAS float*)(sl + FS_GAM + lane * 4) = G;
                *(LAS v4u*)(sl + FS_V + lane * 16) = vreg;
                asm volatile("s_waitcnt lgkmcnt(0)" ::: "memory");
                f32x4 gt[4];
#pragma unroll
                for (int t = 0; t < 4; ++t) {
                    f32x4 acc = {0.f, 0.f, 0.f, 0.f};
#pragma unroll
                    for (int jj = 0; jj < 2; ++jj) acc = __builtin_amdgcn_mfma_f32_16x16x32_bf16(fs_frag(scr, t >> 1, jj, n16, g), fs_frag(sl, t & 1, jj, n16, g), acc, 0, 0, 0);
                    gt[t] = acc;
                }
                asm volatile("s_waitcnt lgkmcnt(0)" ::: "memory");
#pragma unroll
                for (int r = 0; r < 4; ++r) GL[(4 * g + r) * 33 + n16] = gt[0][r];
                asm volatile("s_waitcnt lgkmcnt(0)" ::: "memory");
                if (lane < 16) {
                    f32x2 Np[56]; float Ns[8];
                    { int pi = 0;
#pragma unroll
                      for (int s = 0; s < 15; ++s) {
                          if (!(s & 1)) Ns[s >> 1] = GL[s * 33 + s + 1];
#pragma unroll
                          for (int m = (s >> 1) + 1; m < 8; ++m) { Np[pi] = (f32x2){GL[s * 33 + 2 * m], GL[s * 33 + 2 * m + 1]}; ++pi; }
                      } }
                    f32x2 ac[8];
#pragma unroll
                    for (int m = 0; m < 8; ++m) ac[m] = (f32x2){(lane == 2 * m) ? 1.f : 0.f, (lane == 2 * m + 1) ? 1.f : 0.f};
                    { int pi = 0;
#pragma unroll
                      for (int s = 0; s < 15; ++s) {
                          const float Ts = (s & 1) ? ac[s >> 1].y : ac[s >> 1].x;
                          if (!(s & 1)) ac[s >> 1].y -= Ts * Ns[s >> 1];
                          const f32x2 tv = {Ts, Ts};
#pragma unroll
                          for (int m = (s >> 1) + 1; m < 8; ++m) { ac[m] -= tv * Np[pi]; ++pi; }
                      } }
#pragma unroll
                    for (int t = 0; t < 16; ++t) TL[lane * 17 + t] = (t & 1) ? ac[t >> 1].y : ac[t >> 1].x;
                }
                asm volatile("s_waitcnt lgkmcnt(0)" ::: "memory");
                {   const int m = n16;
                    float aw[8], a23[8];
#pragma unroll
                    for (int i = 0; i < 4; ++i) {
                        const int s = 4 * g + i;
                        const float gzp = gt[2][i], gzr = gt[3][i], gqr = gt[1][i], tv_ = TL[s * 17 + m];
                        aw[i] = (s < m) ? gzp : 0.f;
                        aw[4 + i] = (s <= m) ? gzr : 0.f;
                        a23[i] = tv_;
                        a23[4 + i] = (s <= m) ? -gqr : 0.f;
                    }
                    *(LAS bf16x8*)(sl + FS_AW + lane * 16) = pack8(aw[0], aw[1], aw[2], aw[3], aw[4], aw[5], aw[6], aw[7]);
                    *(LAS bf16x8*)(sl + FS_A23 + lane * 16) = pack8(a23[0], a23[1], a23[2], a23[3], a23[4], a23[5], a23[6], a23[7]);
                }
                asm volatile("s_waitcnt lgkmcnt(0)" ::: "memory");
                if (lane == 0) flg[c % FS_NS] = (unsigned)(c + 1);
            }
        } else {
            f32x4 S0 = {0.f, 0.f, 0.f, 0.f}, S1 = S0, S2 = S0, S3 = S0;
            const f32x4 z4 = {0.f, 0.f, 0.f, 0.f};
            __builtin_amdgcn_s_setprio(2);
            for (int c = 0; c < NCHUNK; ++c) {
                { unsigned sp = 0; while (flg[c % FS_NS] != (unsigned)(c + 1) && ++sp < (1u << 20)) __builtin_amdgcn_s_sleep(1); }
                asm volatile("" ::: "memory");
                const LAS unsigned char* sl = slots + (c % FS_NS) * FS_SLOT;
                bf16x8 a1[4], a4[4];
#pragma unroll
                for (int q = 0; q < 4; ++q) {
                    a1[q] = fs_frag(sl, q >> 1, q & 1, n16, g);
                    const v2u lo = *(const LAS v2u*)(sl + FS_A4 + g * 1024 + (16 * q + n16) * 8), hh = *(const LAS v2u*)(sl + FS_A4 + g * 1024 + 512 + (16 * q + n16) * 8);
                    a4[q] = __builtin_bit_cast(bf16x8, (v4u){lo.x, lo.y, hh.x, hh.y});
                }
                const bf16x8 awm = *(const LAS bf16x8*)(sl + FS_AW + lane * 16), a23 = *(const LAS bf16x8*)(sl + FS_A23 + lane * 16);
                f32x4 gam[4];
#pragma unroll
                for (int kb = 0; kb < 4; ++kb) gam[kb] = *(const LAS f32x4*)(sl + FS_GAM + (kb * 16 + 4 * g) * 4);
                unsigned vv[4];
#pragma unroll
                for (int i = 0; i < 4; ++i) vv[i] = *(const LAS unsigned short*)(sl + FS_V + (4 * g + i) * 64 + (16 * wave + n16) * 2);
                asm volatile("s_waitcnt lgkmcnt(0)" ::: "memory");
                if (lane == 0) flg[8 + wave] = (unsigned)(c + 1);
                const unsigned v01 = vv[0] | (vv[1] << 16), v23 = vv[2] | (vv[3] << 16);
                const bf16x8 VL = mk8(v01, v23, 0u, 0u), VU = mk8(0u, 0u, v01, v23);
                const bf16x8 sb0 = mk8(cvt_pk_bf16_v(S0[0], S0[1]), cvt_pk_bf16_v(S0[2], S0[3]), cvt_pk_bf16_v(S1[0], S1[1]), cvt_pk_bf16_v(S1[2], S1[3]));
                const bf16x8 sb1 = mk8(cvt_pk_bf16_v(S2[0], S2[1]), cvt_pk_bf16_v(S2[2], S2[3]), cvt_pk_bf16_v(S3[0], S3[1]), cvt_pk_bf16_v(S3[2], S3[3]));
                f32x4 accP = __builtin_amdgcn_mfma_f32_16x16x32_bf16(awm, VL, z4, 0, 0, 0);
                f32x4 accR = __builtin_amdgcn_mfma_f32_16x16x32_bf16(awm, VU, z4, 0, 0, 0);
                accP = __builtin_amdgcn_mfma_f32_16x16x32_bf16(a1[0], sb0, accP, 0, 0, 0);
                accR = __builtin_amdgcn_mfma_f32_16x16x32_bf16(a1[2], sb0, accR, 0, 0, 0);
                accP = __builtin_amdgcn_mfma_f32_16x16x32_bf16(a1[1], sb1, accP, 0, 0, 0);
                accR = __builtin_amdgcn_mfma_f32_16x16x32_bf16(a1[3], sb1, accR, 0, 0, 0);
                const bf16x8 RL = mk8(cvt_pk_bf16_v(accP[0], accP[1]), cvt_pk_bf16_v(accP[2], accP[3]), 0u, 0u);
                const f32x4 acc2 = __builtin_amdgcn_mfma_f32_16x16x32_bf16(a23, RL, z4, 0, 0, 0);
                const unsigned u01 = cvt_pk_bf16_v(acc2[0], acc2[1]), u23 = cvt_pk_bf16_v(acc2[2], acc2[3]);
                const bf16x8 UV = mk8(u01, u23, v01, v23), UU = mk8(0u, 0u, u01, u23);
                S0 = __builtin_amdgcn_mfma_f32_16x16x32_bf16(a4[0], UV, S0, 0, 0, 0);
                S1 = __builtin_amdgcn_mfma_f32_16x16x32_bf16(a4[1], UV, S1, 0, 0, 0);
                S2 = __builtin_amdgcn_mfma_f32_16x16x32_bf16(a4[2], UV, S2, 0, 0, 0);
                S3 = __builtin_amdgcn_mfma_f32_16x16x32_bf16(a4[3], UV, S3, 0, 0, 0);
                accR = __builtin_amdgcn_mfma_f32_16x16x32_bf16(a23, UU, accR, 0, 0, 0);
                const int row0 = chunk_row0(b, d, c);
#pragma unroll
                for (int r = 0; r < 4; ++r) Y[dofs + (size_t)(row0 + dstep * (4 * g + r)) * D + h * 64 + vh * 32 + 16 * wave + n16] = (bf16)(cvt_pk_bf16_v(accR[r], 0.f) & 0xffffu);
                S0 *= gam[0]; S1 *= gam[1]; S2 *= gam[2]; S3 *= gam[3];
            }
            __builtin_amdgcn_s_setprio(0);
        }
        __syncthreads();
    }
}
__device__ __forceinline__ void phase_readout(Frame& F, int j, const bf16* Vsrc, int lat_only) {
    const bf16* GG = (const bf16*)(F.ws + WS_GG); const bf16* Y = (const bf16*)(F.ws + WS_Y); const float* BON = (const float*)(F.ws + WS_BON);
    bf16* O = (bf16*)(F.ws + WS_O);
    const float* ln_g = F.in[25] + (size_t)j * D; const float* ln_b = F.in[26] + (size_t)j * D;
    const int nrows = lat_only ? NB * SEQ : M;
    for (int it = F.gw; it < 4 * nrows; it += F.NGW) {
        const int ri = it >> 2, jq = it & 3;
        const int row = lat_only ? (ri / SEQ) * SB + (ri % SEQ) : ri;
#pragma unroll
        for (int j2 = 0; j2 < 2; ++j2) {
            const int jj = 2 * jq + j2;
            const int col = 4 * F.lane + 256 * jj; const size_t o = (size_t)row * D + col; const int head = col >> 6;
            const v2u y0r = *(const v2u*)(Y + o), y1r = *(const v2u*)(Y + (size_t)M * D + o);
            const f32x4 y = (f32x4){bflo(y0r.x) + bflo(y1r.x), bfhi(y0r.x) + bfhi(y1r.x), bflo(y0r.y) + bflo(y1r.y), bfhi(y0r.y) + bfhi(y1r.y)};
            const float bon = BON[(size_t)row * 32 + head] + BON[((size_t)M + row) * 32 + head];
            const float mean = sum16((y.x + y.y) + (y.z + y.w)) * (1.f / 64.f);
            const f32x4 dy = y - mean;
            const float var = sum16((dy.x * dy.x + dy.y * dy.y) + (dy.z * dy.z + dy.w * dy.w)) * (1.f / 64.f);
            const float rs = rsqrtf(var + GN_EPS);
            const v2u vr = *(const v2u*)(Vsrc + o), gr = *(const v2u*)(GG + o);
            const f32x4 v = {bflo(vr.x), bfhi(vr.x), bflo(vr.y), bfhi(vr.y)}, g = {bflo(gr.x), bfhi(gr.x), bflo(gr.y), bfhi(gr.y)};
            const f32x4 lg = *(const f32x4*)(ln_g + col), lb = *(const f32x4*)(ln_b + col);
            const f32x4 ov = (dy * rs * lg + lb + v * bon) * g;
            v2u w; w.x = cvt_pk_bf16(ov.x, ov.y); w.y = cvt_pk_bf16(ov.z, ov.w);
            *(v2u*)(O + o) = w;
        }
    }
}
__device__ __forceinline__ float qk_bound(const float* qg, const float* kg, int lane) {
    float a = fmaxf(fabsf(qg[lane]), fabsf(qg[lane + 64])), b = fmaxf(fabsf(kg[lane]), fabsf(kg[lane + 64]));
#pragma unroll
    for (int o = 1; o < 64; o <<= 1) { a = fmaxf(a, __shfl_xor(a, o)); b = fmaxf(b, __shfl_xor(b, o)); }
    return 128.f * a * b * 1.01f;
}
constexpr float FIXM_LIMIT = 45.f / (att::SCALE * 1.4426950408889634f);
__device__ __forceinline__ void phase_attn_gqa(Frame& F) {
    const bf16* QKV = (const bf16*)(F.ws + WS_QKV); bf16* O = (bf16*)(F.ws + WS_O);
    att::NaInfo na{0, 0, nullptr, 0.f};
    na.mfix = qk_bound(F.in[37], F.in[38], F.lane);
    const bool fixm = na.mfix < FIXM_LIMIT;
    for (int u = F.vcu; u < 512 + 32; u += F.G) {
        int b, h, qrow, NT, first0;
        if (u < 512) { const int kvg = u >> 6; b = kvg >> 2; h = (kvg & 3) * 4 + ((u >> 4) & 3); qrow = (u & 15) * 256; NT = SB / 64; first0 = 0; }
        else { const int v = u - 512; b = v >> 4; h = v & 15; qrow = SEQ; NT = CTXL / 64; first0 = SEQ; }
        const int kvh = h >> 2;
        const bf16* Qb = QKV + ((size_t)b * SB + qrow) * 3072 + h * HD;
        const bf16* Kh = QKV + (size_t)b * SB * 3072 + 2048 + kvh * HD; const bf16* Vh = Kh + 512;
        if (fixm) att::attn_unit<3072, 3072, 2048, false, true>(Qb, Kh, Vh, O + ((size_t)b * SB + qrow) * D + h * HD, NT, NT, first0, 0, (char*)F.ldsg + RING_OFF, na);
        else att::attn_unit<3072, 3072, 2048, false, false>(Qb, Kh, Vh, O + ((size_t)b * SB + qrow) * D + h * HD, NT, NT, first0, 0, (char*)F.ldsg + RING_OFF, na);
    }
}
__device__ __forceinline__ void phase_attn_na(Frame& F, const float* rpb  ) {
    const bf16* QKV = (const bf16*)(F.ws + WS_QKV); bf16* O = (bf16*)(F.ws + WS_O);
    float* tab = (float*)((char*)F.ldsg + RING_OFF + att::SHM_ATTN);
    const float qkb = qk_bound(F.in[32], F.in[33], F.lane);
    const bool bal = (F.G == 256);
    for (int k = 0;; ++k) {
        int u;
        if (bal) { if (k < 2) u = F.vcu + 256 * k; else { const int q = F.vcu & 15; if (k > 2 || (q != 0 && q != 15)) break; u = 512 + (F.vcu >> 4) * 2 + (q == 15 ? 1 : 0); } }
        else { u = F.vcu + F.G * k; if (u >= 512 + 32) break; }
        int b, h, qrow, NT, second0 = 0; att::NaInfo na{0, 0, tab, 0.f};
        if (u < 512) {
            b = u >> 8; h = (u >> 4) & 15; const int qb = u & 15; qrow = qb * 256;
            const int r0 = qb * 4; int rs_lo = r0 - 4; rs_lo = rs_lo < 0 ? 0 : (rs_lo > 56 ? 56 : rs_lo); int rs_hi = r0 + 3 - 4; rs_hi = rs_hi < 0 ? 0 : (rs_hi > 56 ? 56 : rs_hi);
            int nlat = rs_hi + 8 - rs_lo;
            if (nlat & 1) { if (rs_hi + 8 < 64) nlat += 1; else { rs_lo -= 1; nlat += 1; } }
            na.r0 = r0; na.rs_lo = rs_lo; NT = 4 + nlat; second0 = rs_lo * 64;
        } else { const int v = u - 512; b = v >> 4; h = v & 15; qrow = SEQ; NT = 4; }
        float tmax = 0.f;
        for (int i = F.tid; i < 15 * 31; i += 512) { const float tv_ = rpb[h * 465 + i] * (1.0f / att::SCALE); tab[64 + i] = tv_; tmax = fmaxf(tmax, fabsf(tv_)); }
#pragma unroll
        for (int o = 1; o < 64; o <<= 1) tmax = fmaxf(tmax, __shfl_xor(tmax, o));
        if (F.lane == 0) tab[32 + F.wave] = tmax;
        __syncthreads();
#pragma unroll
        for (int w = 0; w < 8; ++w) tmax = fmaxf(tmax, tab[32 + w]);
        na.mfix = qkb + tmax;
        const bool fixm = na.mfix < FIXM_LIMIT;
        const bf16* Qb = QKV + ((size_t)b * SB + qrow) * 6144 + h * HD;
        const bf16* Kh = QKV + (size_t)b * SB * 6144 + 2048 + h * HD; const bf16* Vh = Kh + 2048;
        if (fixm) att::attn_unit_simple<6144, 6144, 2048, true, true>(Qb, Kh, Vh, O + ((size_t)b * SB + qrow) * D + h * HD, NT, 4, SEQ, second0, (char*)F.ldsg + RING_OFF, na);
        else att::attn_unit_simple<6144, 6144, 2048, true, false>(Qb, Kh, Vh, O + ((size_t)b * SB + qrow) * D + h * HD, NT, 4, SEQ, second0, (char*)F.ldsg + RING_OFF, na);
    }
}
__device__ __forceinline__ void phase_convfix(Frame& F, const float* cw  , const float* cb  , int lat_only) {
    const float* HALO = (const float*)(F.ws + WS_HALO); bf16* ACT = (bf16*)(F.ws + WS_ACT);
    for (int wi = F.gw; wi < 2 * (M / 64) * 22; wi += F.NGW) {
        const int it = wi / 22, i = wi - it * 22;
        const int g = it >> 1, last = it & 1, row = g * 64 + (last ? 63 : 0);
        int pos, len; const int s_ = row_seqinfo(row, pos, len);
        if (lat_only && s_ == 2) continue;
        const bool hp = pos > 0, hn = pos + 1 < len;
        const float* pm = HALO + (size_t)(last ? g * 4 + 2 : (g - 1) * 4 + 3) * DFF2;
        const float* p0 = HALO + (size_t)(last ? g * 4 + 3 : g * 4 + 0) * DFF2;
        const float* pp = HALO + (size_t)(last ? (g + 1) * 4 + 0 : g * 4 + 1) * DFF2;
        const f32x4 z = {0.f, 0.f, 0.f, 0.f};
        {
            const int f = (i * 64 + F.lane) * 4;
            f32x4 r[2];
#pragma unroll
            for (int half = 0; half < 2; ++half) {
                const int c = f + half * DFF;
                const f32x4 um = hp ? *(const f32x4*)(pm + c) : z, u0 = *(const f32x4*)(p0 + c), up = hn ? *(const f32x4*)(pp + c) : z;
                r[half] = *(const f32x4*)(cb + c) + *(const f32x4*)(cw + c) * um + *(const f32x4*)(cw + DFF2 + c) * u0 + *(const f32x4*)(cw + 2 * DFF2 + c) * up;
            }
            float o[4];
#pragma unroll
            for (int e = 0; e < 4; ++e) o[e] = r[0][e] * r[1][e] * __builtin_amdgcn_rcpf(1.f + __expf(-r[0][e]));
            v2u w; w.x = cvt_pk_bf16(o[0], o[1]); w.y = cvt_pk_bf16(o[2], o[3]);
            *(v2u*)(ACT + (size_t)row * DFF + f) = w;
        }
    }
}

constexpr int PH_PER_LAYER = 12, N_PHASES = 1 + DEPTH * PH_PER_LAYER;
__global__ void __launch_bounds__(512, 2) fwd(Args args) {
    extern __shared__ __attribute__((aligned(16))) unsigned char lds[];
    Frame F;
    F.lds = (LAS unsigned char*)lds; F.ldsg = lds;
    F.tid = threadIdx.x; F.lane = F.tid & 63; F.wave = __builtin_amdgcn_readfirstlane(F.tid >> 6);
    F.G = gridDim.x; { const int bx = blockIdx.x; F.vcu = (F.G % 8 == 0) ? (bx % 8) * (F.G / 8) + bx / 8 : bx; }
    F.gw = F.vcu * 8 + F.wave; F.NGW = F.G * 8;
    F.ws = args.ws; F.in = args.in; F.out = args.out;
    volatile LAS unsigned* MISC = (volatile LAS unsigned*)(F.lds + MISC_OFF);
    for (int u = F.tid; u < (LDS_BYTES - LDSCTL_OFF) / 4; u += 512) ((LAS unsigned*)(F.lds + LDSCTL_OFF))[u] = 0u;
    __syncthreads();
    const int lo = args.ph_lo, hi = args.ph_hi;
    XcdBarrier bar; bar.bar = (unsigned*)(F.ws + WS_CTL) + CW_BAR; bar.x = 0; bar.st = nullptr;
    if (hi - lo > 1) bar = xcd_barrier_post((unsigned*)(F.ws + WS_CTL) + CW_BAR, MISC + 8);
#ifndef PHMASK
#define PHMASK 0xFFFFFFFFu
#endif
#ifndef REPMASK
#define REPMASK 0u
#endif
#define CT(b) ((PHMASK >> (b)) & 1u)
#define NREP(b) (CT(b) ? (((REPMASK >> (b)) & 1u) ? 2 : 1) : 0)
#define REPF(b) for (int rep_ = 0; rep_ < NREP(b); ++rep_)
#define IN(k) (lo <= (k) && (k) < hi)
#define REFRESH() do { F.tid = ltid(); F.lane = F.tid & 63; F.wave = __builtin_amdgcn_readfirstlane(F.tid >> 6); F.gw = F.vcu * 8 + F.wave; } while (0)
#define SEAM(k) do { if (IN((k) + 1)) xcd_barrier(bar); } while (0)
    const float* MOD = (const float*)(F.ws + WS_MOD);
    bf16* X = (bf16*)(F.ws + WS_X);
    bf16* H = (bf16*)(F.ws + WS_H); bf16* Obuf = (bf16*)(F.ws + WS_O);

    if (IN(0)) { REFRESH(); REPF(0) pro_transposes(F); REPF(1) pro_small(F); __syncthreads(); REPF(3) pro_mod(F); SEAM(0); }

    for (int l = 0; l < DEPTH; ++l) {
        const int kind = l % 3, j = l / 3, P = 1 + l * PH_PER_LAYER;
        const float* modl = MOD + (size_t)l * 3 * 12288;
        const int lat3 = (l == DEPTH - 1) ? 1 : 0;
        if (IN(P + 0)) { REFRESH(); REPF(4) phase_norm(F, F.in[6] + (size_t)l * D, modl, H, nullptr, l > 0 ? 11 : 0, modl - 3 * 12288 + 2 * 12288 + 5 * D, 0, l == 0 ? F.in[0] : nullptr, l == 0 ? F.in[2] : nullptr); SEAM(P + 0); }
        if (IN(P + 1)) { REFRESH();
            if (kind == 0) { REPF(5) phase_xm(F, F.in[12] + (size_t)j * 6 * D); }
            else REPF(6) {
                pg8::Gemm g{H, (const bf16*)(F.ws + (kind == 1 ? WS_NAQKVT : WS_GAQKVT)), D};
                pg8::MultiOrder S{&g_ord[kind == 1 ? ORD_N24 : ORD_N12], NMB, F.G, (int)blockIdx.x, 0, 32};
                EpiQKV E{(bf16*)(F.ws + WS_QKV), kind == 1 ? 6144 : 3072, kind == 1 ? 16 : 10, 8, F.in[kind == 1 ? 32 : 37], F.in[kind == 1 ? 33 : 38], kind == 1 ? 0 : 1,
                         (LAS float*)(F.lds + LDSCTL_OFF + 512)};
                pg8::gemm_phase<EpiQKV, pg8::MultiOrder, true, true>(F.lds + RING_OFF, g, S, E);
            }
            SEAM(P + 1);
        }
        if (IN(P + 2) && kind == 0) { REFRESH();
            if (kind == 0) { REPF(7) {
                pg8::Gemm g{(const bf16*)(F.ws + WS_XM), (const bf16*)(F.ws + WS_RWT) + (size_t)j * 28 * 256 * 2048, D};
                pg8::MultiOrder S{&g_ord[j == 0 ? ORD_RW0 : ORD_RW1], NMB, F.G, (int)blockIdx.x, 0, 32};
                EpiGen E{F.ws, g_od[j == 0 ? OD_RW0 : OD_RW1], F.in};
                pg8::gemm_phase<EpiGen, pg8::MultiOrder, true, true>(F.lds + RING_OFF, g, S, E); }
            }
            SEAM(P + 2);
        }
        if (IN(P + 3)) { REFRESH();
            if (kind == 0) { REPF(10) {
                pg8::Gemm g{(const bf16*)(F.ws + WS_L1O), (const bf16*)(F.ws + WS_RL2T) + (size_t)j * 48 * 256 * 256, 256};
                pg8::Lora2Order S{&g_ord[j == 0 ? ORD_L20 : ORD_L21], NMB, F.G, (int)blockIdx.x};
                EpiGen E{F.ws, g_od[j == 0 ? OD_L20 : OD_L21], F.in};
                pg8::gemm_phase<EpiGen, pg8::Lora2Order, true, true>(F.lds + RING_OFF, g, S, E); }
                REFRESH(); phase_rs(F, j);
            } else if (kind == 1) { REPF(11) phase_attn_na(F, F.in[34]); }
            else { REPF(12) phase_attn_gqa(F); }
            SEAM(P + 3);
        }
        if (kind == 0) {
            const bf16* Vsrc = (const bf16*)(F.ws + (j == 0 ? WS_V0 : WS_RKV + 2 * SZ_ACT));

            if (IN(P + 5)) { REFRESH(); REPF(14) phase_scanfused(F, j, Vsrc); SEAM(P + 5); }
            if (IN(P + 6)) { REFRESH(); REPF(15) phase_readout(F, j, j == 0 ? Vsrc : (const bf16*)(F.ws + WS_VF), lat3); SEAM(P + 6); }
        }
        if (IN(P + 7)) { REFRESH(); if (CT(16)) {
            const size_t wo = (kind == 0) ? (WS_RWOT + (size_t)j * 2048 * 2048 * 2) : (kind == 1 ? WS_NAOT : WS_GAOT);
            pg8::Gemm g{Obuf, (const bf16*)(F.ws + wo), D};
            pg8::SplitCtxOrder S{F.G, (int)blockIdx.x, 32, 8, 4, lat3 ? 0 : 1};
            EpiRes E{X, modl + 2 * D, nullptr, (float*)(F.ws + WS_PART), (l == 0) ? F.in[0] : nullptr};
            pg8::gemm_phase<EpiRes, pg8::SplitCtxOrder, true, true>(F.lds + RING_OFF, g, S, E); }
            SEAM(P + 7);
        }
        if (IN(P + 8)) { REFRESH(); REPF(4) phase_norm(F, F.in[7] + (size_t)l * D, modl + 3 * D, H, nullptr, lat3 ? 0 : 8, modl + 2 * 12288 + 2 * D, lat3); SEAM(P + 8); }
        if (IN(P + 9)) { REFRESH(); REPF(17) {
            pg8::Gemm g{H, (const bf16*)(F.ws + WS_UPT) + (size_t)l * DFF2 * D, D};
            pg8::BlockOrder S{F.G, (int)blockIdx.x, lat3, 32};
            EpiUp E{(bf16*)(F.ws + WS_ACT), (float*)(F.ws + WS_HALO), F.in[9] + (size_t)l * 3 * DFF2, F.in[10] + (size_t)l * DFF2};
            pg8::gemm_phase<EpiUp, pg8::BlockOrder, true, true>(F.lds + RING_OFF, g, S, E); }
            SEAM(P + 9);
        }
        if (IN(P + 10)) { REFRESH(); REPF(18) phase_convfix(F, F.in[9] + (size_t)l * 3 * DFF2, F.in[10] + (size_t)l * DFF2, lat3); SEAM(P + 10); }
        if (IN(P + 11)) { REFRESH(); if (CT(19)) {
            pg8::Gemm g{(const bf16*)(F.ws + WS_ACT), (const bf16*)(F.ws + WS_DNT) + (size_t)l * D * DFF, DFF};
            pg8::SplitCtxOrder S{F.G, (int)blockIdx.x, 88, 11, 8, lat3 ? 0 : 1};
            EpiRes E{X, modl + 5 * D, (l == DEPTH - 1) ? F.out : nullptr, (float*)(F.ws + WS_PART), nullptr};
            pg8::gemm_phase<EpiRes, pg8::SplitCtxOrder, true, true>(F.lds + RING_OFF, g, S, E); }
            SEAM(P + 11);
        }
    }
#undef IN
#undef SEAM
}

extern "C" void kernel_launch(void* const* d_in, const int* in_sizes, int n_in, void* d_out, int out_size, void* d_ws, size_t ws_size, hipStream_t stream) {
    static int grid = 0;
    if (grid == 0) {
        if (n_in != 40 || out_size != NB * SEQ * D || ws_size < WS_END) { fprintf(stderr, "kernel_launch: unexpected shapes (n_in %d out %d ws %zu need %zu)\n", n_in, out_size, ws_size, (size_t)WS_END); grid = -1; return; }
        int dev = 0, cus = 0;
        if (hipGetDevice(&dev) != hipSuccess || hipDeviceGetAttribute(&cus, hipDeviceAttributeMultiprocessorCount, dev) != hipSuccess) { grid = -1; return; }
        if (hipFuncSetAttribute((const void*)fwd, hipFuncAttributeMaxDynamicSharedMemorySize, LDS_BYTES) != hipSuccess) { fprintf(stderr, "kernel_launch: hipFuncSetAttribute failed\n"); grid = -1; return; }
        int per_cu = 0;
        if (hipOccupancyMaxActiveBlocksPerMultiprocessor(&per_cu, (const void*)fwd, 512, LDS_BYTES) != hipSuccess || per_cu < 1) fprintf(stderr, "kernel_launch: occupancy query says %d\n", per_cu);
        (void)hipGetLastError();
        grid = cus;
    }
    if (grid < 0) return;
    (void)hipMemsetAsync((char*)d_ws + WS_CTL, 0, CTL_ZERO_BYTES, stream);
    Args a{};
    for (int i = 0; i < 40; ++i) a.in[i] = (const float*)d_in[i];
    a.out = (float*)d_out; a.ws = (unsigned char*)d_ws;
#if MK_ONE_LAUNCH
    a.ph_lo = 0; a.ph_hi = N_PHASES;
    hipLaunchKernelGGL(fwd, dim3(grid), dim3(512), LDS_BYTES, stream, a);
#else
    for (int ph = 0; ph < N_PHASES; ++ph) {
        if (ph > 0) { const int l = (ph - 1) / PH_PER_LAYER, k = (ph - 1) % PH_PER_LAYER, kind = l % 3, j = l / 3;
            if (kind != 0 && (k == 4 || k == 5 || k == 6)) continue;
            if (kind == 0 && k == 4) continue; }
        a.ph_lo = ph; a.ph_hi = ph + 1;
        hipLaunchKernelGGL(fwd, dim3(grid), dim3(512), LDS_BYTES, stream, a);
    }
#endif
    const hipError_t le = hipPeekAtLastError();
    if (le != hipSuccess) fprintf(stderr, "kernel_launch: launch failed: %s\n", hipGetErrorName(le));
}
```
